# Optimizing an MI355X kernel written in HIP

```python
import jax, jax.numpy as jnp
from jax import lax
import numpy as np

D_MODEL = 1024
BATCH = 4
SEQ = 4096
DEPTH = 2

CHUNK = 64
LEFT_CHUNKS = 8
BAND_CHUNKS = LEFT_CHUNKS + 1
N_HEADS = 16
HEAD_DIM = D_MODEL // N_HEADS
REL_CLIP = 128
LRU_WIDTH = ((4 * D_MODEL // 3 + 127) // 128) * 128
N_LRU_BLOCKS = 16
LRU_BLOCK = LRU_WIDTH // N_LRU_BLOCKS
LRU_C = 8.0
CONV_WIDTH = 4
D_FF = 4 * D_MODEL
N_A_LAYERS = DEPTH // 2
N_B_LAYERS = DEPTH - N_A_LAYERS
EPS = 1e-6

kernel_name = "yoco_rglru_chunk_relbias_trunk"


def rms_norm(x, g):
    xf = x.astype(jnp.float32)
    y = xf * lax.rsqrt(jnp.mean(xf * xf, axis=-1, keepdims=True) + EPS)
    return (y * g.astype(jnp.float32)).astype(x.dtype)


def modulate(x, shift, scale):
    return x * (1 + scale[:, None, :]) + shift[:, None, :]


def causal_depthwise_conv(x, w, b):
    y = lax.conv_general_dilated(
        x, w[:, None, :].astype(x.dtype), window_strides=(1,),
        padding=[(CONV_WIDTH - 1, 0)],
        dimension_numbers=("NWC", "WIO", "NWC"),
        feature_group_count=x.shape[-1])
    return y + b


def rg_lru(x, w_a, b_a, w_x, b_x, lam):
    bsz, s, w = x.shape
    xb = x.reshape(bsz, s, N_LRU_BLOCKS, LRU_BLOCK)
    r = jax.nn.sigmoid(jnp.einsum("bsnd,nde->bsne", xb, w_a).reshape(bsz, s, w) + b_a)
    i = jax.nn.sigmoid(jnp.einsum("bsnd,nde->bsne", xb, w_x).reshape(bsz, s, w) + b_x)
    log_a = (-LRU_C * r.astype(jnp.float32)) * jax.nn.softplus(-lam.astype(jnp.float32))
    a = jnp.exp(log_a)
    mult = jnp.sqrt(-jnp.expm1(2.0 * log_a))
    u = mult * (i * x).astype(jnp.float32)

    def combine(left, right):
        a_l, b_l = left
        a_r, b_r = right
        return a_r * a_l, a_r * b_l + b_r

    _, h = lax.associative_scan(combine, (a, u), axis=1)
    return h.astype(x.dtype)


def recurrent_mixer(hn, w_in, conv_w, conv_b, gate_a_w, gate_a_b, gate_x_w, gate_x_b, lam, w_out):
    z = hn @ w_in
    gate, xr = jnp.split(z, 2, axis=-1)
    xr = causal_depthwise_conv(xr, conv_w, conv_b)
    y = rg_lru(xr, gate_a_w, gate_a_b, gate_x_w, gate_x_b, lam)
    return (y * jax.nn.gelu(gate)) @ w_out


def shared_kv(h, c_act, kv_norm_g, kv_ada_w, kv_ada_b, kv_w, k_norm_g):
    bsz, s, _ = h.shape
    shift, scale = jnp.split(c_act @ kv_ada_w + kv_ada_b, 2, axis=-1)
    hn = modulate(rms_norm(h, kv_norm_g), shift, scale)
    k, v = jnp.split(hn @ kv_w, 2, axis=-1)
    k = rms_norm(k.reshape(bsz, s, N_HEADS, HEAD_DIM), k_norm_g)
    v = v.reshape(bsz, s, N_HEADS, HEAD_DIM)
    pad = ((0, 0), (LEFT_CHUNKS * CHUNK, 0), (0, 0), (0, 0))
    return jnp.pad(k, pad), jnp.pad(v, pad)


def chunk_attention(hn, w_q, q_norm_g, rel_bias, w_o, k_pad, v_pad):
    bsz, s, d = hn.shape
    n_chunks = s // CHUNK
    band = BAND_CHUNKS * CHUNK
    left = LEFT_CHUNKS * CHUNK
    q = rms_norm((hn @ w_q).reshape(bsz, s, N_HEADS, HEAD_DIM), q_norm_g)
    q_chunks = q.reshape(bsz, n_chunks, CHUNK, N_HEADS, HEAD_DIM).transpose(1, 0, 2, 3, 4)
    rel = jnp.arange(CHUNK)[:, None] - (jnp.arange(band)[None, :] - left)
    rel_idx = jnp.clip(rel, -REL_CLIP, REL_CLIP) + REL_CLIP
    bias = rel_bias[:, rel_idx].astype(jnp.float32)
    scale = HEAD_DIM ** -0.5

    def one_chunk(args):
        qc, ci = args
        start = ci * CHUNK
        kc = lax.dynamic_slice_in_dim(k_pad, start, band, axis=1)
        vc = lax.dynamic_slice_in_dim(v_pad, start, band, axis=1)
        sc = jnp.einsum("bqhd,bkhd->bhqk", qc, kc,
                        preferred_element_type=jnp.float32) * scale + bias
        valid = (start - left + jnp.arange(band)) >= 0
        sc = jnp.where(valid[None, None, None, :], sc, -1e30)
        p = jax.nn.softmax(sc, axis=-1).astype(vc.dtype)
        return jnp.einsum("bhqk,bkhd->bqhd", p, vc)

    out = lax.map(one_chunk, (q_chunks, jnp.arange(n_chunks)))
    out = out.transpose(1, 0, 2, 3, 4).reshape(bsz, s, d)
    return out @ w_o


def sqrelu_mlp(hn, w1, w2):
    return jnp.square(jax.nn.relu(hn @ w1)) @ w2


def setup_inputs(seed: int = 0) -> dict:
    key = jax.random.key(seed)
    ks = jax.random.split(key, 32)
    f32 = jnp.float32
    D, W = D_MODEL, LRU_WIDTH

    def nrm(k, shape, fan_in):
        return jax.random.normal(k, shape, f32) * (fan_in ** -0.5)

    u = jax.random.uniform(ks[10], (N_A_LAYERS, W), f32, 0.9, 0.999)
    a0 = u ** (1.0 / LRU_C)
    lru_lambda = jnp.log(a0) - jnp.log1p(-a0)
    return {
        "x": jax.random.normal(ks[0], (BATCH, SEQ, D), f32),
        "c": jax.random.normal(ks[1], (BATCH, D), f32),
        "ada_w": nrm(ks[2], (DEPTH, D, 6 * D), D),
        "ada_b": 0.02 * jax.random.normal(ks[3], (DEPTH, 6 * D), f32),
        "norm1_g": 1.0 + 0.05 * jax.random.normal(ks[4], (DEPTH, D), f32),
        "norm2_g": 1.0 + 0.05 * jax.random.normal(ks[5], (DEPTH, D), f32),
        "mlp_w1": nrm(ks[6], (DEPTH, D, D_FF), D),
        "mlp_w2": nrm(ks[7], (DEPTH, D_FF, D), D_FF),
        "lru_w_in": nrm(ks[8], (N_A_LAYERS, D, 2 * W), D),
        "lru_conv_w": nrm(ks[9], (N_A_LAYERS, CONV_WIDTH, W), CONV_WIDTH),
        "lru_conv_b": 0.02 * jax.random.normal(ks[11], (N_A_LAYERS, W), f32),
        "lru_gate_a_w": nrm(ks[12], (N_A_LAYERS, N_LRU_BLOCKS, LRU_BLOCK, LRU_BLOCK), LRU_BLOCK),
        "lru_gate_a_b": 0.02 * jax.random.normal(ks[13], (N_A_LAYERS, W), f32),
        "lru_gate_x_w": nrm(ks[14], (N_A_LAYERS, N_LRU_BLOCKS, LRU_BLOCK, LRU_BLOCK), LRU_BLOCK),
        "lru_gate_x_b": 0.02 * jax.random.normal(ks[15], (N_A_LAYERS, W), f32),
        "lru_lambda": lru_lambda,
        "lru_w_out": nrm(ks[16], (N_A_LAYERS, W, D), W),
        "kv_norm_g": 1.0 + 0.05 * jax.random.normal(ks[17], (D,), f32),
        "kv_ada_w": nrm(ks[18], (D, 2 * D), D),
        "kv_ada_b": 0.02 * jax.random.normal(ks[19], (2 * D,), f32),
        "kv_w": nrm(ks[20], (D, 2 * D), D),
        "k_norm_g": 1.0 + 0.05 * jax.random.normal(ks[21], (HEAD_DIM,), f32),
        "attn_w_q": nrm(ks[22], (N_B_LAYERS, D, D), D),
        "q_norm_g": 1.0 + 0.05 * jax.random.normal(ks[23], (N_B_LAYERS, HEAD_DIM), f32),
        "rel_bias": 0.5 * jax.random.normal(ks[24], (N_B_LAYERS, N_HEADS, 2 * REL_CLIP + 1), f32),
        "attn_w_o": nrm(ks[25], (N_B_LAYERS, D, D), D),
    }


def reference(x, c, ada_w, ada_b, norm1_g, norm2_g, mlp_w1, mlp_w2,
              lru_w_in, lru_conv_w, lru_conv_b, lru_gate_a_w, lru_gate_a_b,
              lru_gate_x_w, lru_gate_x_b, lru_lambda, lru_w_out,
              kv_norm_g, kv_ada_w, kv_ada_b, kv_w, k_norm_g,
              attn_w_q, q_norm_g, rel_bias, attn_w_o):
    c_act = jax.nn.silu(c)
    h = x
    k_pad = None
    v_pad = None
    for layer in range(DEPTH):
        mod = c_act @ ada_w[layer] + ada_b[layer]
        sh1, sc1, g1, sh2, sc2, g2 = jnp.split(mod, 6, axis=-1)
        hn = modulate(rms_norm(h, norm1_g[layer]), sh1, sc1)
        if layer < N_A_LAYERS:
            y = recurrent_mixer(hn, lru_w_in[layer], lru_conv_w[layer], lru_conv_b[layer],
                                lru_gate_a_w[layer], lru_gate_a_b[layer],
                                lru_gate_x_w[layer], lru_gate_x_b[layer],
                                lru_lambda[layer], lru_w_out[layer])
        else:
            j = layer - N_A_LAYERS
            y = chunk_attention(hn, attn_w_q[j], q_norm_g[j], rel_bias[j], attn_w_o[j],
                                k_pad, v_pad)
        h = h + g1[:, None, :] * y
        hn = modulate(rms_norm(h, norm2_g[layer]), sh2, sc2)
        h = h + g2[:, None, :] * sqrelu_mlp(hn, mlp_w1[layer], mlp_w2[layer])
        if layer == N_A_LAYERS - 1:
            k_pad, v_pad = shared_kv(h, c_act, kv_norm_g, kv_ada_w, kv_ada_b, kv_w, k_norm_g)
    return h
```

```cpp
#include <hip/hip_runtime.h>
#include <cstdio>
#include <cstdint>

#define GAS __attribute__((address_space(1)))
#define LAS __attribute__((address_space(3)))
typedef unsigned short bf16;
typedef unsigned v4u __attribute__((ext_vector_type(4)));
typedef float f32x4 __attribute__((ext_vector_type(4)));

constexpr int BATCH = 4, SEQ = 4096, D = 1024, M = BATCH * SEQ;
constexpr int W = 1408, NLB = 16, LB = 88, FF = 4096, H = 16, HD = 64, CHUNK = 64, LEFT = 8;
constexpr float EPS = 1e-6f;
constexpr float QSCALE = 0.125f * 1.4426950408889634f;
constexpr float LOG2E = 1.4426950408889634f;

constexpr size_t MiB = 1u << 20;
constexpr size_t WS_CTL = 0, CTL_ZERO_BYTES = 1 * MiB;
constexpr size_t WS_MOD0 = 1 * MiB, WS_MOD1 = WS_MOD0 + 4 * 6144 * 4, WS_KVMOD = WS_MOD1 + 4 * 6144 * 4;
constexpr size_t WS_LRUA = 2 * MiB, WS_LRUH = WS_LRUA + (size_t)BATCH * 64 * W * 4;
constexpr size_t WS_WIN = 8 * MiB;
constexpr size_t WS_WOUT = WS_WIN + (size_t)2 * W * D * 2;
constexpr size_t WS_W1 = WS_WOUT + (size_t)D * W * 2;
constexpr size_t WS_W2 = WS_W1 + (size_t)2 * FF * D * 2;
constexpr size_t WS_WQKV = WS_W2 + (size_t)2 * FF * D * 2;
constexpr size_t WS_WO = WS_WQKV + (size_t)3 * D * D * 2;
constexpr size_t WS_WEND = WS_WO + (size_t)D * D * 2;
constexpr size_t WS_HNA = 58 * MiB;
constexpr size_t WS_YG = 90 * MiB;
constexpr size_t WS_HNB = WS_YG;
constexpr size_t WS_BIG = 128 * MiB;
constexpr size_t WS_Z = WS_BIG + 8 * MiB;
constexpr size_t WS_Q = WS_BIG, WS_K = WS_BIG + 32 * MiB, WS_V = WS_BIG + 64 * MiB, WS_O = WS_BIG + 96 * MiB;
constexpr size_t WS_END = 256 * MiB;
static_assert(WS_WEND <= WS_HNA && WS_LRUH + (size_t)BATCH * 64 * W * 4 <= WS_WIN && WS_YG + (size_t)M * W * 2 <= WS_Z && WS_Z + (size_t)M * 2 * W * 2 <= WS_END, "ws map");

__device__ __forceinline__ unsigned f2bf(float f) { unsigned u = __builtin_bit_cast(unsigned, f); return (u + 0x7fffu + ((u >> 16) & 1u)) >> 16; }
__device__ __forceinline__ unsigned pk2(float lo, float hi) { return f2bf(lo) | (f2bf(hi) << 16); }
__device__ __forceinline__ float bf2f(unsigned h) { return __builtin_bit_cast(float, h << 16); }
__device__ __forceinline__ float wave_sum(float v) {
#pragma unroll
    for (int o = 1; o < 64; o <<= 1) v += __shfl_xor(v, o);
    return v;
}
__device__ __forceinline__ float sigmoidf_(float x) { return 1.f / (1.f + __expf(-x)); }
__device__ __forceinline__ float gelu_tanh(float x) { const float u = 0.7978845608028654f * (x + 0.044715f * x * x * x); return 0.5f * x * (1.f + tanhf(u)); }

constexpr int NWAVES = 8, NTHREADS = 512;
constexpr int LDS_BYTES = 147456;
struct Args {
    const float* in[26]; float* out; unsigned char* ws; int ph_lo, ph_hi, perm_qk, pad;
};
enum Phase { P_PRO = 0, P_NORM_A1, P_GEMM_IN, P_LRU1, P_LRU2, P_GEMM_OUT, P_NORM_A2, P_UP0, P_DN0, P_NORM_B, P_QKV, P_ATTN, P_GEMM_O, P_NORM_B2, P_UP1, P_DN1, P_COUNT };

struct Frame {
    LAS unsigned char* lds; int tid, lane, wave, G;
};

__device__ __forceinline__ int qk_perm_row(int n) { const int L = n & 255; return (n & ~255) + 128 * ((L >> 5) & 1) + 32 * (L >> 6) + (L & 31); }
__device__ __forceinline__ void p0_transpose_item(const float* Wsrc, int K, int N, bf16* WT, int row_off, int perm_below, LAS float* scr, int item, int lane) {
    const int nblk = N / 32, kb = item / nblk, nb = item % nblk, k0 = 64 * kb, n0 = 32 * nb;
#pragma unroll 8
    for (int i = 0; i < 32; ++i) { const int kk = 2 * i + (lane >> 5); scr[kk * 33 + (lane & 31)] = Wsrc[(size_t)(k0 + kk) * N + n0 + (lane & 31)]; }
    asm volatile("s_waitcnt lgkmcnt(0)" ::: "memory");
    const int c = lane & 7;
#pragma unroll
    for (int j = 0; j < 4; ++j) { const int n = (lane >> 3) + 8 * j; const LAS float* s = scr + (8 * c) * 33 + n;
        v4u o; o.x = pk2(s[0 * 33], s[1 * 33]); o.y = pk2(s[2 * 33], s[3 * 33]); o.z = pk2(s[4 * 33], s[5 * 33]); o.w = pk2(s[6 * 33], s[7 * 33]);
        int drow = row_off + n0 + n; if (drow < perm_below) drow = qk_perm_row(drow);
        *(GAS v4u*)(WT + (size_t)drow * K + k0 + 8 * c) = o; }
    asm volatile("s_waitcnt lgkmcnt(0)" ::: "memory");
}

__device__ __forceinline__ void p0_prologue(Frame& F, const Args& a) {
    unsigned char* ws = a.ws;
    {
        LAS float* cact = (LAS float*)(F.lds);
        LAS float* red = (LAS float*)(F.lds + 16384);
        const float* c = a.in[1];
        for (int i = F.tid; i < BATCH * D; i += NTHREADS) { const float v = c[i]; cact[i] = v / (1.f + __expf(-v)); }
        __syncthreads();
        for (int item = blockIdx.x; item < 224; item += F.G) {
            const int gc = item * 64; const float* Wp; const float* bp; float* op; int N, j0;
            if (gc < 6144) { Wp = a.in[2]; bp = a.in[3]; op = (float*)(ws + WS_MOD0); N = 6144; j0 = gc; }
            else if (gc < 12288) { Wp = a.in[2] + (size_t)D * 6144; bp = a.in[3] + 6144; op = (float*)(ws + WS_MOD1); N = 6144; j0 = gc - 6144; }
            else { Wp = a.in[18]; bp = a.in[19]; op = (float*)(ws + WS_KVMOD); N = 2048; j0 = gc - 12288; }
            float a0 = 0.f, a1 = 0.f, a2 = 0.f, a3 = 0.f;
            const int kbase = F.wave * 128;
            const float* wp = Wp + (size_t)kbase * N + j0 + F.lane;
#pragma unroll 8
            for (int k = 0; k < 128; ++k) { const float w = wp[(size_t)k * N]; const int kk = kbase + k;
                a0 += cact[kk] * w; a1 += cact[1024 + kk] * w; a2 += cact[2048 + kk] * w; a3 += cact[3072 + kk] * w; }
            red[(F.wave * 4 + 0) * 64 + F.lane] = a0; red[(F.wave * 4 + 1) * 64 + F.lane] = a1; red[(F.wave * 4 + 2) * 64 + F.lane] = a2; red[(F.wave * 4 + 3) * 64 + F.lane] = a3;
            __syncthreads();
            if (F.tid < 256) { const int b = F.tid >> 6, l = F.tid & 63; float s = 0.f;
#pragma unroll
                for (int w = 0; w < 8; ++w) s += red[(w * 4 + b) * 64 + l];
                op[(size_t)b * N + j0 + l] = s + bp[j0 + l]; }
            __syncthreads();
        }
    }
    {
        LAS float* scr = (LAS float*)(F.lds + 32768 + F.wave * 12288);
        const int gw = blockIdx.x * NWAVES + F.wave, NGW = F.G * NWAVES;
        constexpr int I_IN = (D / 64) * (2 * W / 32), I_OUT = (W / 64) * (D / 32), I_1 = (D / 64) * (FF / 32), I_2 = (FF / 64) * (D / 32), I_Q = (D / 64) * (D / 32), I_KV = (D / 64) * (2 * D / 32), I_O = I_Q;
        constexpr int NITEMS = I_IN + I_OUT + 2 * I_1 + 2 * I_2 + I_Q + I_KV + I_O;
        const int permq = a.perm_qk ? D : 0, permkv = a.perm_qk ? 2 * D : 0;
        for (int it = gw; it < NITEMS; it += NGW) {
            int r = it;
            if (r < I_IN) { p0_transpose_item(a.in[8], D, 2 * W, (bf16*)(ws + WS_WIN), 0, 0, scr, r, F.lane); continue; } r -= I_IN;
            if (r < I_OUT) { p0_transpose_item(a.in[16], W, D, (bf16*)(ws + WS_WOUT), 0, 0, scr, r, F.lane); continue; } r -= I_OUT;
            if (r < I_1) { p0_transpose_item(a.in[6], D, FF, (bf16*)(ws + WS_W1), 0, 0, scr, r, F.lane); continue; } r -= I_1;
            if (r < I_1) { p0_transpose_item(a.in[6] + (size_t)D * FF, D, FF, (bf16*)(ws + WS_W1) + (size_t)FF * D, 0, 0, scr, r, F.lane); continue; } r -= I_1;
            if (r < I_2) { p0_transpose_item(a.in[7], FF, D, (bf16*)(ws + WS_W2), 0, 0, scr, r, F.lane); continue; } r -= I_2;
            if (r < I_2) { p0_transpose_item(a.in[7] + (size_t)D * FF, FF, D, (bf16*)(ws + WS_W2) + (size_t)FF * D, 0, 0, scr, r, F.lane); continue; } r -= I_2;
            if (r < I_Q) { p0_transpose_item(a.in[22], D, D, (bf16*)(ws + WS_WQKV), 0, permq, scr, r, F.lane); continue; } r -= I_Q;
            if (r < I_KV) { p0_transpose_item(a.in[20], D, 2 * D, (bf16*)(ws + WS_WQKV), D, permkv, scr, r, F.lane); continue; } r -= I_KV;
            p0_transpose_item(a.in[25], D, D, (bf16*)(ws + WS_WO), 0, 0, scr, r, F.lane);
        }
    }
}

__device__ __forceinline__ void norm_rows(Frame& F, const float* src, const float* g, const float* shift, const float* scale, int mstride, bf16* dst,
                                          const float* g2, const float* shift2, const float* scale2, int mstride2, bf16* dst2) {
    const int gw = blockIdx.x * NWAVES + F.wave, NGW = F.G * NWAVES;
    for (int m = gw; m < M; m += NGW) {
        const int b = m / SEQ;
        const GAS f32x4* xr = (const GAS f32x4*)(src + (size_t)m * D) + F.lane;
        f32x4 v[4]; float s = 0.f;
#pragma unroll
        for (int j = 0; j < 4; ++j) { v[j] = xr[64 * j]; s += (v[j].x * v[j].x + v[j].y * v[j].y) + (v[j].z * v[j].z + v[j].w * v[j].w); }
        const float rstd = 1.f / sqrtf(wave_sum(s) * (1.f / D) + EPS);
        {
            const GAS f32x4* gp = (const GAS f32x4*)g + F.lane; const GAS f32x4* sh = (const GAS f32x4*)(shift + (size_t)b * mstride) + F.lane; const GAS f32x4* sc = (const GAS f32x4*)(scale + (size_t)b * mstride) + F.lane;
            GAS unsigned long long* o8 = (GAS unsigned long long*)(dst + (size_t)m * D) + F.lane;
#pragma unroll
            for (int j = 0; j < 4; ++j) { const f32x4 gg = gp[64 * j], hh = sh[64 * j], cc = sc[64 * j];
                const f32x4 y = (v[j] * rstd) * gg * (cc + 1.f) + hh;
                o8[64 * j] = (unsigned long long)pk2(y.x, y.y) | ((unsigned long long)pk2(y.z, y.w) << 32); }
        }
        if (dst2) {
            const GAS f32x4* gp = (const GAS f32x4*)g2 + F.lane; const GAS f32x4* sh = (const GAS f32x4*)(shift2 + (size_t)b * mstride2) + F.lane; const GAS f32x4* sc = (const GAS f32x4*)(scale2 + (size_t)b * mstride2) + F.lane;
            GAS unsigned long long* o8 = (GAS unsigned long long*)(dst2 + (size_t)m * D) + F.lane;
#pragma unroll
            for (int j = 0; j < 4; ++j) { const f32x4 gg = gp[64 * j], hh = sh[64 * j], cc = sc[64 * j];
                const f32x4 y = (v[j] * rstd) * gg * (cc + 1.f) + hh;
                o8[64 * j] = (unsigned long long)pk2(y.x, y.y) | ((unsigned long long)pk2(y.z, y.w) << 32); }
        }
    }
}

__global__ void __launch_bounds__(NTHREADS, 2) mk_fwd(Args args) {
    extern __shared__ __attribute__((aligned(16))) unsigned char lds[];
    Frame F; F.lds = (LAS unsigned char*)lds; F.tid = threadIdx.x; F.lane = F.tid & 63; F.wave = __builtin_amdgcn_readfirstlane(F.tid >> 6); F.G = gridDim.x;
    unsigned char* ws = args.ws;
    const int lo = args.ph_lo, hi = args.ph_hi;
#define IN(k) (lo <= (k) && (k) < hi)
    float* mod0 = (float*)(ws + WS_MOD0); float* mod1 = (float*)(ws + WS_MOD1); float* kvmod = (float*)(ws + WS_KVMOD);
    if (IN(P_PRO)) { p0_prologue(F, args); }
    if (IN(P_NORM_A1)) { norm_rows(F, args.in[0], args.in[4], mod0 + 0, mod0 + 1024, 6144, (bf16*)(ws + WS_HNA), nullptr, nullptr, nullptr, 0, nullptr); }
    if (IN(P_NORM_A2)) { norm_rows(F, args.out, args.in[5], mod0 + 3072, mod0 + 4096, 6144, (bf16*)(ws + WS_HNA), nullptr, nullptr, nullptr, 0, nullptr); }
    if (IN(P_NORM_B)) { norm_rows(F, args.out, args.in[4] + D, mod1 + 0, mod1 + 1024, 6144, (bf16*)(ws + WS_HNA), args.in[17], kvmod + 0, kvmod + 1024, 2048, (bf16*)(ws + WS_HNB)); }
    if (IN(P_NORM_B2)) { norm_rows(F, args.out, args.in[5] + D, mod1 + 3072, mod1 + 4096, 6144, (bf16*)(ws + WS_HNA), nullptr, nullptr, nullptr, 0, nullptr); }
#undef IN
}

struct NEpi {
    int mode;
    bf16* O; int ldc;
    const float* base; float* out; const float* gate; int gstride;
    const float* qg; const float* kg; bf16* Q; bf16* Kb; bf16* V;
};
__global__ void __launch_bounds__(256) naive_gemm(const bf16* A, const bf16* A2, int a2_from_col, const bf16* Bt, int N, int K, NEpi e) {
    __shared__ float As[32][65];
    __shared__ float Bs[32][65];
    __shared__ float red[64][17];
    const int t = threadIdx.x, tx = t & 15, ty = t >> 4;
    const int m0 = blockIdx.y * 64, n0 = blockIdx.x * 64;
    const bf16* Ause = (n0 >= a2_from_col) ? A2 : A;
    float acc[4][4];
#pragma unroll
    for (int i = 0; i < 4; ++i)
#pragma unroll
        for (int j = 0; j < 4; ++j) acc[i][j] = 0.f;
    const int lr = t >> 2, lc = t & 3;
    for (int k0 = 0; k0 < K; k0 += 32) {
        const v4u av = *(const v4u*)(Ause + (size_t)(m0 + lr) * K + k0 + lc * 8);
        const v4u bv = *(const v4u*)(Bt + (size_t)(n0 + lr) * K + k0 + lc * 8);
        __syncthreads();
        As[lc * 8 + 0][lr] = bf2f(av.x & 0xffffu); As[lc * 8 + 1][lr] = bf2f(av.x >> 16); As[lc * 8 + 2][lr] = bf2f(av.y & 0xffffu); As[lc * 8 + 3][lr] = bf2f(av.y >> 16);
        As[lc * 8 + 4][lr] = bf2f(av.z & 0xffffu); As[lc * 8 + 5][lr] = bf2f(av.z >> 16); As[lc * 8 + 6][lr] = bf2f(av.w & 0xffffu); As[lc * 8 + 7][lr] = bf2f(av.w >> 16);
        Bs[lc * 8 + 0][lr] = bf2f(bv.x & 0xffffu); Bs[lc * 8 + 1][lr] = bf2f(bv.x >> 16); Bs[lc * 8 + 2][lr] = bf2f(bv.y & 0xffffu); Bs[lc * 8 + 3][lr] = bf2f(bv.y >> 16);
        Bs[lc * 8 + 4][lr] = bf2f(bv.z & 0xffffu); Bs[lc * 8 + 5][lr] = bf2f(bv.z >> 16); Bs[lc * 8 + 6][lr] = bf2f(bv.w & 0xffffu); Bs[lc * 8 + 7][lr] = bf2f(bv.w >> 16);
        __syncthreads();
#pragma unroll
        for (int k = 0; k < 32; ++k) {
            float av4[4], bv4[4];
#pragma unroll
            for (int i = 0; i < 4; ++i) { av4[i] = As[k][ty * 4 + i]; bv4[i] = Bs[k][tx * 4 + i]; }
#pragma unroll
            for (int i = 0; i < 4; ++i)
#pragma unroll
                for (int j = 0; j < 4; ++j) acc[i][j] += av4[i] * bv4[j];
        }
    }
    if (e.mode == 0 || e.mode == 1) {
#pragma unroll
        for (int i = 0; i < 4; ++i) { const int row = m0 + ty * 4 + i;
#pragma unroll
            for (int j = 0; j < 4; ++j) { float v = acc[i][j]; if (e.mode == 1) { v = v > 0.f ? v : 0.f; v = v * v; }
                e.O[(size_t)row * e.ldc + n0 + tx * 4 + j] = (bf16)f2bf(v); } }
    } else if (e.mode == 2) {
#pragma unroll
        for (int i = 0; i < 4; ++i) { const int row = m0 + ty * 4 + i; const int b = row / SEQ;
#pragma unroll
            for (int j = 0; j < 4; ++j) { const int col = n0 + tx * 4 + j;
                e.out[(size_t)row * D + col] = e.base[(size_t)row * D + col] + e.gate[(size_t)b * e.gstride + col] * acc[i][j]; } }
    } else {
        const int tsel = n0 / D, cbase = n0 % D;
        bf16* dst = tsel == 0 ? e.Q : (tsel == 1 ? e.Kb : e.V);
        float rs[4] = {1.f, 1.f, 1.f, 1.f};
        if (tsel < 2) {
#pragma unroll
            for (int i = 0; i < 4; ++i) { float p = 0.f;
#pragma unroll
                for (int j = 0; j < 4; ++j) p += acc[i][j] * acc[i][j];
                red[ty * 4 + i][tx] = p; }
            __syncthreads();
#pragma unroll
            for (int i = 0; i < 4; ++i) { float s = 0.f;
                for (int x = 0; x < 16; ++x) s += red[ty * 4 + i][x];
                rs[i] = 1.f / sqrtf(s * (1.f / HD) + EPS); }
        }
#pragma unroll
        for (int i = 0; i < 4; ++i) { const int row = m0 + ty * 4 + i;
#pragma unroll
            for (int j = 0; j < 4; ++j) { const int d = tx * 4 + j; float v = acc[i][j];
                if (tsel == 0) v = v * rs[i] * e.qg[d] * QSCALE; else if (tsel == 1) v = v * rs[i] * e.kg[d];
                dst[(size_t)row * D + cbase + d] = (bf16)f2bf(v); } }
    }
}

__global__ void __launch_bounds__(128) naive_lru(const bf16* Z, const float* conv_w, const float* conv_b, const float* wa, const float* ba, const float* wx, const float* bx, const float* lam, bf16* YG) {
    __shared__ float swa[LB * LB];
    __shared__ float swx[LB * LB];
    __shared__ float xcs[LB];
    const int b = blockIdx.x / NLB, n = blockIdx.x % NLB, e = threadIdx.x;
    for (int i = e; i < LB * LB; i += 128) { swa[i] = wa[(size_t)n * LB * LB + i]; swx[i] = wx[(size_t)n * LB * LB + i]; }
    const int ch = n * LB + (e < LB ? e : 0);
    const float cw0 = conv_w[0 * W + ch], cw1 = conv_w[1 * W + ch], cw2 = conv_w[2 * W + ch], cw3 = conv_w[3 * W + ch], cb = conv_b[ch];
    const float bav = ba[ch], bxv = bx[ch];
    const float sp = log1pf(__expf(-lam[ch]));
    float x0 = 0.f, x1 = 0.f, x2 = 0.f, h = 0.f;
    __syncthreads();
    for (int t = 0; t < SEQ; ++t) {
        const size_t row = (size_t)b * SEQ + t;
        const float x3 = bf2f(Z[row * (2 * W) + W + ch]);
        const float gt = bf2f(Z[row * (2 * W) + ch]);
        const float xc = cb + cw0 * x0 + cw1 * x1 + cw2 * x2 + cw3 * x3;
        x0 = x1; x1 = x2; x2 = x3;
        if (e < LB) xcs[e] = xc;
        __syncthreads();
        if (e < LB) {
            float pa = bav, px = bxv;
            for (int d = 0; d < LB; ++d) { const float xd = xcs[d]; pa += xd * swa[d * LB + e]; px += xd * swx[d * LB + e]; }
            const float r = sigmoidf_(pa), ig = sigmoidf_(px);
            const float la = -8.f * r * sp;
            const float av = __expf(la);
            const float mult = sqrtf(-expm1f(2.f * la));
            h = av * h + mult * (ig * xc);
            YG[row * W + ch] = (bf16)f2bf(h * gelu_tanh(gt));
        }
        __syncthreads();
    }
}

__global__ void __launch_bounds__(64) naive_attn(const bf16* Q, const bf16* Kb, const bf16* V, const float* rel_bias, bf16* O) {
    const int ci = blockIdx.x % (SEQ / CHUNK), h = (blockIdx.x / (SEQ / CHUNK)) % H, b = blockIdx.x / (SEQ / CHUNK * H);
    const int qi = threadIdx.x, qpos = ci * CHUNK + qi;
    const size_t qrow = (size_t)b * SEQ + qpos;
    float q[HD];
#pragma unroll
    for (int d = 0; d < HD; ++d) q[d] = bf2f(Q[qrow * D + h * HD + d]);
    const int k_lo = (ci - LEFT) * CHUNK < 0 ? 0 : (ci - LEFT) * CHUNK, k_hi = (ci + 1) * CHUNK;
    const float* rb = rel_bias + h * 257;
    float mx = -1e30f;
    for (int kp = k_lo; kp < k_hi; ++kp) {
        const v4u* kr = (const v4u*)(Kb + ((size_t)b * SEQ + kp) * D + h * HD); float s = 0.f;
#pragma unroll
        for (int c = 0; c < 8; ++c) { const v4u kv = kr[c];
            s += q[8 * c + 0] * bf2f(kv.x & 0xffffu) + q[8 * c + 1] * bf2f(kv.x >> 16) + q[8 * c + 2] * bf2f(kv.y & 0xffffu) + q[8 * c + 3] * bf2f(kv.y >> 16)
               + q[8 * c + 4] * bf2f(kv.z & 0xffffu) + q[8 * c + 5] * bf2f(kv.z >> 16) + q[8 * c + 6] * bf2f(kv.w & 0xffffu) + q[8 * c + 7] * bf2f(kv.w >> 16); }
        int rel = qpos - kp; rel = rel < -128 ? -128 : (rel > 128 ? 128 : rel);
        s += rb[rel + 128] * LOG2E;
        mx = s > mx ? s : mx;
    }
    float o[HD]; float l = 0.f;
#pragma unroll
    for (int d = 0; d < HD; ++d) o[d] = 0.f;
    for (int kp = k_lo; kp < k_hi; ++kp) {
        const v4u* kr = (const v4u*)(Kb + ((size_t)b * SEQ + kp) * D + h * HD); float s = 0.f;
#pragma unroll
        for (int c = 0; c < 8; ++c) { const v4u kv = kr[c];
            s += q[8 * c + 0] * bf2f(kv.x & 0xffffu) + q[8 * c + 1] * bf2f(kv.x >> 16) + q[8 * c + 2] * bf2f(kv.y & 0xffffu) + q[8 * c + 3] * bf2f(kv.y >> 16)
               + q[8 * c + 4] * bf2f(kv.z & 0xffffu) + q[8 * c + 5] * bf2f(kv.z >> 16) + q[8 * c + 6] * bf2f(kv.w & 0xffffu) + q[8 * c + 7] * bf2f(kv.w >> 16); }
        int rel = qpos - kp; rel = rel < -128 ? -128 : (rel > 128 ? 128 : rel);
        s += rb[rel + 128] * LOG2E;
        const float p = exp2f(s - mx); l += p;
        const v4u* vr = (const v4u*)(V + ((size_t)b * SEQ + kp) * D + h * HD);
#pragma unroll
        for (int c = 0; c < 8; ++c) { const v4u vv = vr[c];
            o[8 * c + 0] += p * bf2f(vv.x & 0xffffu); o[8 * c + 1] += p * bf2f(vv.x >> 16); o[8 * c + 2] += p * bf2f(vv.y & 0xffffu); o[8 * c + 3] += p * bf2f(vv.y >> 16);
            o[8 * c + 4] += p * bf2f(vv.z & 0xffffu); o[8 * c + 5] += p * bf2f(vv.z >> 16); o[8 * c + 6] += p * bf2f(vv.w & 0xffffu); o[8 * c + 7] += p * bf2f(vv.w >> 16); }
    }
    const float il = 1.f / l;
#pragma unroll
    for (int d = 0; d < HD; ++d) O[qrow * D + h * HD + d] = (bf16)f2bf(o[d] * il);
}

extern "C" void kernel_launch(void* const* d_in, const int* in_sizes, int n_in, void* d_out, int out_size, void* d_ws, size_t ws_size, hipStream_t stream) {
    static int grid = 0;
    if (grid == 0) {
        if (n_in != 26 || out_size != M * D || ws_size < WS_END) { fprintf(stderr, "kernel_launch: unexpected shapes (n_in %d out %d ws %zu)\n", n_in, out_size, ws_size); grid = -1; return; }
        int dev = 0, cus = 0;
        if (hipGetDevice(&dev) != hipSuccess || hipDeviceGetAttribute(&cus, hipDeviceAttributeMultiprocessorCount, dev) != hipSuccess) { grid = -1; return; }
        if (hipFuncSetAttribute((const void*)mk_fwd, hipFuncAttributeMaxDynamicSharedMemorySize, LDS_BYTES) != hipSuccess) { fprintf(stderr, "kernel_launch: hipFuncSetAttribute failed\n"); grid = -1; return; }
        (void)hipGetLastError();
        grid = cus;
    }
    if (grid < 0) return;
    unsigned char* ws = (unsigned char*)d_ws;
    (void)hipMemsetAsync(ws + WS_CTL, 0, CTL_ZERO_BYTES, stream);
    Args a{};
    for (int i = 0; i < 26; ++i) a.in[i] = (const float*)d_in[i];
    a.out = (float*)d_out; a.ws = ws; a.perm_qk = 0;
    float* out = (float*)d_out; const float* x = (const float*)d_in[0];
    float* mod0 = (float*)(ws + WS_MOD0); float* mod1 = (float*)(ws + WS_MOD1);
    bf16* HNA = (bf16*)(ws + WS_HNA); bf16* HNB = (bf16*)(ws + WS_HNB); bf16* YG = (bf16*)(ws + WS_YG); bf16* Z = (bf16*)(ws + WS_Z); bf16* HB = (bf16*)(ws + WS_BIG);
    bf16* Qb = (bf16*)(ws + WS_Q); bf16* Kb = (bf16*)(ws + WS_K); bf16* Vb = (bf16*)(ws + WS_V); bf16* Ob = (bf16*)(ws + WS_O);
    bf16* WIN = (bf16*)(ws + WS_WIN); bf16* WOUT = (bf16*)(ws + WS_WOUT); bf16* W1 = (bf16*)(ws + WS_W1); bf16* W2 = (bf16*)(ws + WS_W2); bf16* WQKV = (bf16*)(ws + WS_WQKV); bf16* WO = (bf16*)(ws + WS_WO);
    auto mk = [&](int p) { a.ph_lo = p; a.ph_hi = p + 1; hipLaunchKernelGGL(mk_fwd, dim3(grid), dim3(NTHREADS), LDS_BYTES, stream, a); };
    auto gemm = [&](const bf16* A, const bf16* A2, int a2col, const bf16* Bt, int N, int K, NEpi e) { hipLaunchKernelGGL(naive_gemm, dim3(N / 64, M / 64), dim3(256), 0, stream, A, A2, a2col, Bt, N, K, e); };
    mk(P_PRO);
    mk(P_NORM_A1);
    { NEpi e{}; e.mode = 0; e.O = Z; e.ldc = 2 * W; gemm(HNA, HNA, 1 << 30, WIN, 2 * W, D, e); }
    hipLaunchKernelGGL(naive_lru, dim3(BATCH * NLB), dim3(128), 0, stream, Z, (const float*)d_in[9], (const float*)d_in[10], (const float*)d_in[11], (const float*)d_in[12], (const float*)d_in[13], (const float*)d_in[14], (const float*)d_in[15], YG);
    { NEpi e{}; e.mode = 2; e.base = x; e.out = out; e.gate = mod0 + 2048; e.gstride = 6144; gemm(YG, YG, 1 << 30, WOUT, D, W, e); }
    mk(P_NORM_A2);
    { NEpi e{}; e.mode = 1; e.O = HB; e.ldc = FF; gemm(HNA, HNA, 1 << 30, W1, FF, D, e); }
    { NEpi e{}; e.mode = 2; e.base = out; e.out = out; e.gate = mod0 + 5120; e.gstride = 6144; gemm(HB, HB, 1 << 30, W2, D, FF, e); }
    mk(P_NORM_B);
    { NEpi e{}; e.mode = 3; e.qg = (const float*)d_in[23]; e.kg = (const float*)d_in[21]; e.Q = Qb; e.Kb = Kb; e.V = Vb; gemm(HNA, HNB, D, WQKV, 3 * D, D, e); }
    hipLaunchKernelGGL(naive_attn, dim3(BATCH * H * (SEQ / CHUNK)), dim3(64), 0, stream, Qb, Kb, Vb, (const float*)d_in[24], Ob);
    { NEpi e{}; e.mode = 2; e.base = out; e.out = out; e.gate = mod1 + 2048; e.gstride = 6144; gemm(Ob, Ob, 1 << 30, WO, D, D, e); }
    mk(P_NORM_B2);
    { NEpi e{}; e.mode = 1; e.O = HB; e.ldc = FF; gemm(HNA, HNA, 1 << 30, W1 + (size_t)FF * D, FF, D, e); }
    { NEpi e{}; e.mode = 2; e.base = out; e.out = out; e.gate = mod1 + 5120; e.gstride = 6144; gemm(HB, HB, 1 << 30, W2 + (size_t)FF * D, D, FF, e); }
}
```

```cpp
#include <hip/hip_runtime.h>
#include <cstdio>
#include <cstdint>

#define GAS __attribute__((address_space(1)))
#define LAS __attribute__((address_space(3)))
typedef unsigned short bf16;
typedef unsigned v4u __attribute__((ext_vector_type(4)));
typedef float f32x4 __attribute__((ext_vector_type(4)));

constexpr int BATCH = 4, SEQ = 4096, D = 1024, M = BATCH * SEQ;
constexpr int W = 1408, NLB = 16, LB = 88, FF = 4096, H = 16, HD = 64, CHUNK = 64, LEFT = 8;
constexpr float EPS = 1e-6f;
constexpr float QSCALE = 0.125f * 1.4426950408889634f;
constexpr float LOG2E = 1.4426950408889634f;

constexpr size_t MiB = 1u << 20;
constexpr size_t WS_CTL = 0, CTL_ZERO_BYTES = 1 * MiB;
constexpr size_t WS_MOD0 = 1 * MiB, WS_MOD1 = WS_MOD0 + 4 * 6144 * 4, WS_KVMOD = WS_MOD1 + 4 * 6144 * 4;
constexpr size_t WS_LRUA = 2 * MiB, WS_LRUH = WS_LRUA + (size_t)BATCH * 64 * W * 4;
constexpr size_t WS_WIN = 8 * MiB;
constexpr size_t WS_WOUT = WS_WIN + (size_t)2 * W * D * 2;
constexpr size_t WS_W1 = WS_WOUT + (size_t)D * W * 2;
constexpr size_t WS_W2 = WS_W1 + (size_t)2 * FF * D * 2;
constexpr size_t WS_WQKV = WS_W2 + (size_t)2 * FF * D * 2;
constexpr size_t WS_WO = WS_WQKV + (size_t)3 * D * D * 2;
constexpr size_t WS_WEND = WS_WO + (size_t)D * D * 2;
constexpr size_t WS_HNA = 58 * MiB;
constexpr size_t WS_YG = 90 * MiB;
constexpr size_t WS_HNB = WS_YG;
constexpr size_t WS_BIG = 128 * MiB;
constexpr size_t WS_Z = WS_BIG + 8 * MiB;
constexpr size_t WS_Q = WS_BIG, WS_K = WS_BIG + 32 * MiB, WS_V = WS_BIG + 64 * MiB, WS_O = WS_BIG + 96 * MiB;
constexpr size_t WS_END = 256 * MiB;
static_assert(WS_WEND <= WS_HNA && WS_LRUH + (size_t)BATCH * 64 * W * 4 <= WS_WIN && WS_YG + (size_t)M * W * 2 <= WS_Z && WS_Z + (size_t)M * 2 * W * 2 <= WS_END, "ws map");

__device__ __forceinline__ unsigned f2bf(float f) { unsigned u = __builtin_bit_cast(unsigned, f); return (u + 0x7fffu + ((u >> 16) & 1u)) >> 16; }
__device__ __forceinline__ unsigned pk2(float lo, float hi) { return f2bf(lo) | (f2bf(hi) << 16); }
__device__ __forceinline__ float bf2f(unsigned h) { return __builtin_bit_cast(float, h << 16); }
__device__ __forceinline__ float wave_sum(float v) {
#pragma unroll
    for (int o = 1; o < 64; o <<= 1) v += __shfl_xor(v, o);
    return v;
}
__device__ __forceinline__ float sigmoidf_(float x) { return 1.f / (1.f + __expf(-x)); }
__device__ __forceinline__ float gelu_tanh(float x) { const float u = 0.7978845608028654f * (x + 0.044715f * x * x * x); return 0.5f * x * (1.f + tanhf(u)); }


namespace pg8 {
#define PG8_LAS __attribute__((address_space(3)))
typedef unsigned short bf16_t;
typedef short bf16x8 __attribute__((ext_vector_type(8)));
typedef float f32x4 __attribute__((ext_vector_type(4)));
typedef unsigned u32x4 __attribute__((ext_vector_type(4)));
constexpr int BM = 256, BK = 64, HALF = 128, HTB = HALF * BK * 2, STAGE_BYTES = 8 * HTB, NXCD = 8, WGM = 8;
__host__ __device__ __forceinline__ int lds_byte(int r, int c) { const int st = (r >> 4) * 2 + (c >> 5), rr = r & 15, cc = c & 31, ob = rr * 64 + cc * 2; return st * 1024 + (ob ^ (((ob >> 9) & 1) << 5)); }
__host__ __device__ __forceinline__ void stage_rc(int b, int& R, int& C) { const int st = b / 1024, sb = b % 1024, swz = sb ^ (((sb >> 9) & 1) << 5); R = (st >> 1) * 16 + swz / 64; C = (st & 1) * 32 + (swz % 64) / 2; }
__host__ __device__ __forceinline__ int perm32(int rho) { const int n = rho >> 4, i = rho & 15; return 8 * (i >> 2) + 4 * n + (i & 3); }
struct Unit { int pm, pn; };
struct Gemm { const bf16_t* A; const bf16_t* A2; int a2_pn; const bf16_t* Bt; int M, N, K; };
struct StaticOrder {
    int nM, nN, nwg, G, c;
    __host__ __device__ void init(int M, int N, int G_, int c_) { nM = M / BM; nN = N / BM; nwg = nM * nN; G = G_; c = c_; }
    __host__ __device__ bool next(int i, Unit& u) const {
        const long L = (long)i * G + c; if (L >= nwg) return false;
        int wgid = (int)L; { const int q = nwg / NXCD, r = nwg % NXCD, xcd = wgid % NXCD, off = wgid / NXCD; wgid = (xcd < r ? xcd * (q + 1) : r * (q + 1) + (xcd - r) * q) + off; }
        const int nig = WGM * nN, gid = wgid / nig, fm = gid * WGM, gsz = (nM - fm) < WGM ? (nM - fm) : WGM;
        u.pm = fm + ((wgid % nig) % gsz); u.pn = (wgid % nig) / gsz; return true;
    }
    __device__ __forceinline__ void a_ready(const Unit&) const {}
    __device__ __forceinline__ void done(const Unit&) const {}
};
__device__ __forceinline__ unsigned cvt_pk_bf16(float lo, float hi) { unsigned r; asm volatile("v_cvt_pk_bf16_f32 %0, %1, %2" : "=v"(r) : "v"(lo), "v"(hi)); return r; }

template <int ACT  > struct EpiBf16 {
    static constexpr bool PERM = true, AFTER_DRAIN = false;
    bf16_t* O; int ldc;
    __device__ __forceinline__ void operator()(const f32x4 (&acc)[2][2][4][2], const Unit& u, int wr, int wc, int fr, int fq) const {
        const int row0 = u.pm * BM + wr * 64 + fr; const int col0 = u.pn * BM + wc * 32 + 8 * fq;
#pragma unroll
        for (int ai = 0; ai < 2; ++ai)
#pragma unroll
            for (int m = 0; m < 4; ++m) { bf16_t* rowp = O + (size_t)(row0 + ai * HALF + m * 16) * ldc + col0;
#pragma unroll
                for (int bj = 0; bj < 2; ++bj) { f32x4 v0 = acc[ai][bj][m][0], v1 = acc[ai][bj][m][1];
                    if (ACT == 2) {
#pragma unroll
                        for (int e = 0; e < 4; ++e) { const float a = v0[e] > 0.f ? v0[e] : 0.f, b = v1[e] > 0.f ? v1[e] : 0.f; v0[e] = a * a; v1[e] = b * b; } }
                    u32x4 w; w.x = cvt_pk_bf16(v0[0], v0[1]); w.y = cvt_pk_bf16(v0[2], v0[3]); w.z = cvt_pk_bf16(v1[0], v1[1]); w.w = cvt_pk_bf16(v1[2], v1[3]);
                    *(u32x4*)(rowp + bj * HALF) = w; } }
    }
};
struct EpiQKV {
    static constexpr bool PERM = true, AFTER_DRAIN = false;
    bf16_t* Q; bf16_t* K; bf16_t* V; const float* qg; const float* kg; float qscale, eps;
    __device__ __forceinline__ void operator()(const f32x4 (&acc)[2][2][4][2], const Unit& u, int wr, int wc, int fr, int fq) const {
        const int row0 = u.pm * BM + wr * 64 + fr; const int tsel = u.pn >> 2, ct = (u.pn & 3) * BM;
        if (tsel == 2) {
            const int col0 = ct + wc * 32 + 8 * fq;
#pragma unroll
            for (int ai = 0; ai < 2; ++ai)
#pragma unroll
                for (int m = 0; m < 4; ++m) { bf16_t* rowp = V + (size_t)(row0 + ai * HALF + m * 16) * 1024 + col0;
#pragma unroll
                    for (int bj = 0; bj < 2; ++bj) { const f32x4 v0 = acc[ai][bj][m][0], v1 = acc[ai][bj][m][1];
                        u32x4 w; w.x = cvt_pk_bf16(v0[0], v0[1]); w.y = cvt_pk_bf16(v0[2], v0[3]); w.z = cvt_pk_bf16(v1[0], v1[1]); w.w = cvt_pk_bf16(v1[2], v1[3]);
                        *(u32x4*)(rowp + bj * HALF) = w; } }
        } else {
            bf16_t* dst = tsel == 0 ? Q : K; const float* g = tsel == 0 ? qg : kg; const float sc = tsel == 0 ? qscale : 1.f;
            f32x4 gv[2][2];
#pragma unroll
            for (int bj = 0; bj < 2; ++bj)
#pragma unroll
                for (int n = 0; n < 2; ++n) gv[bj][n] = *(const f32x4*)(g + 32 * bj + 8 * fq + 4 * n) * sc;
            const int col0 = ct + 64 * wc + 8 * fq;
#pragma unroll
            for (int ai = 0; ai < 2; ++ai)
#pragma unroll
                for (int m = 0; m < 4; ++m) {
                    float s = 0.f;
#pragma unroll
                    for (int bj = 0; bj < 2; ++bj)
#pragma unroll
                        for (int n = 0; n < 2; ++n) { const f32x4 x = acc[ai][bj][m][n]; s += (x[0] * x[0] + x[1] * x[1]) + (x[2] * x[2] + x[3] * x[3]); }
                    s += __shfl_xor(s, 16); s += __shfl_xor(s, 32);
                    const float rstd = 1.0f / sqrtf(s * (1.0f / 64.0f) + eps);
                    bf16_t* rowp = dst + (size_t)(row0 + ai * HALF + m * 16) * 1024 + col0;
#pragma unroll
                    for (int bj = 0; bj < 2; ++bj) { const f32x4 v0 = acc[ai][bj][m][0] * rstd * gv[bj][0], v1 = acc[ai][bj][m][1] * rstd * gv[bj][1];
                        u32x4 w; w.x = cvt_pk_bf16(v0[0], v0[1]); w.y = cvt_pk_bf16(v0[2], v0[3]); w.z = cvt_pk_bf16(v1[0], v1[1]); w.w = cvt_pk_bf16(v1[2], v1[3]);
                        *(u32x4*)(rowp + bj * 32) = w; } }
        }
    }
};
struct EpiRes {
    static constexpr bool PERM = false, AFTER_DRAIN = false;
    const float* base; float* out; const float* gate; int gstride, rows_per_batch;
    __device__ __forceinline__ void operator()(const f32x4 (&acc)[2][2][4][2], const Unit& u, int wr, int wc, int fr, int fq) const {
        const int b = (u.pm * BM) / rows_per_batch; const int col0 = u.pn * BM + wc * 32 + 4 * fq;
        f32x4 gv[2][2];
#pragma unroll
        for (int bj = 0; bj < 2; ++bj)
#pragma unroll
            for (int n = 0; n < 2; ++n) gv[bj][n] = *(const f32x4*)(gate + (size_t)b * gstride + col0 + bj * HALF + n * 16);
#pragma unroll
        for (int ai = 0; ai < 2; ++ai)
#pragma unroll
            for (int m = 0; m < 4; ++m) { const size_t off = (size_t)(u.pm * BM + ai * HALF + wr * 64 + m * 16 + fr) * 1024 + col0;
#pragma unroll
                for (int bj = 0; bj < 2; ++bj)
#pragma unroll
                    for (int n = 0; n < 2; ++n) { const f32x4 bs = *(const f32x4*)(base + off + bj * HALF + n * 16);
                        *(f32x4*)(out + off + bj * HALF + n * 16) = bs + gv[bj][n] * acc[ai][bj][m][n]; }
                if (m & 1) asm volatile("" ::: "memory"); }
    }
};

template <class Epi, class Sched, bool ALIGN_EPI = false, bool SP2 = false>
__device__ __forceinline__ void gemm_phase(PG8_LAS unsigned char* lds, const Gemm g, const Sched& S, const Epi& E) {
    const int tid = threadIdx.x, wid = __builtin_amdgcn_readfirstlane(tid >> 6), lane = tid & 63, wr = wid >> 2, wc = wid & 3, fr = lane & 15, fq = lane >> 4;
    const int K = g.K, nt = K / BK;
    unsigned voffA[2], voffB[2];
#pragma unroll
    for (int i = 0; i < 2; ++i) { int R, C; stage_rc(tid * 16 + i * 8192, R, C); const int Rb = Epi::PERM ? ((R & ~31) + perm32(R & 31)) : R;
        voffA[i] = (unsigned)(R * K + C) * 2u; voffB[i] = (unsigned)(Rb * K + C) * 2u; }
    const size_t kstep = (size_t)(BK * 2);
    const size_t hstep = (size_t)HALF * K * 2;
    const size_t tstep = 2 * hstep;
    const unsigned ldsw = (unsigned)wid * 1024u;
    const int aoff = lds_byte(wr * 64 + fr, fq * 8), boff = lds_byte(wc * 32 + fr, fq * 8);
#define PG8_SA(b, h) (((b) * 2 + (h)) * HTB)
#define PG8_SB(b, h) ((4 + (b) * 2 + (h)) * HTB)
#define PG8_STAGE(bufoff, gbase, voff) do { _Pragma("unroll") for (int _i = 0; _i < 2; ++_i) \
        __builtin_amdgcn_global_load_lds((const unsigned*)((const char*)(gbase) + (voff)[_i]), (PG8_LAS unsigned*)(lds + (bufoff) + ldsw + _i * 8192), 16, 0, 0); } while (0)
#define PG8_LDA(dst, b, h) do { _Pragma("unroll") for (int m = 0; m < 4; ++m) _Pragma("unroll") for (int k = 0; k < 2; ++k) dst[m][k] = *(const PG8_LAS bf16x8*)(lds + PG8_SA(b, h) + aoff + m * 2048 + k * 1024); } while (0)
#define PG8_LDB(dst, b, h) do { _Pragma("unroll") for (int n = 0; n < 2; ++n) _Pragma("unroll") for (int k = 0; k < 2; ++k) dst[n][k] = *(const PG8_LAS bf16x8*)(lds + PG8_SB(b, h) + boff + n * 2048 + k * 1024); } while (0)
#define PG8_MMA(ai, bj, At, Bt) do { __builtin_amdgcn_s_setprio(1); _Pragma("unroll") for (int m = 0; m < 4; ++m) _Pragma("unroll") for (int n = 0; n < 2; ++n) _Pragma("unroll") for (int k = 0; k < 2; ++k) \
        acc[ai][bj][m][n] = __builtin_amdgcn_mfma_f32_16x16x32_bf16(Bt[n][k], At[m][k], acc[ai][bj][m][n], 0, 0, 0); __builtin_amdgcn_s_setprio(0); } while (0)
#define PG8_WAIT_V(n) asm volatile("s_waitcnt vmcnt(" #n ")" ::: "memory")
#define PG8_WAIT_L(n) asm volatile("s_waitcnt lgkmcnt(" #n ")" ::: "memory")
#define PG8_BAR __builtin_amdgcn_s_barrier()
#define PG8_SCHED __builtin_amdgcn_sched_barrier(0)
#define PG8_ABASE(u) ((const char*)((u).pn >= g.a2_pn ? g.A2 : g.A) + (size_t)(u).pm * tstep)
    Unit cur, nxt; int ui = 0;
    if (!S.next(0, cur)) return;
    f32x4 acc[2][2][4][2];
#pragma unroll
    for (int a = 0; a < 2; ++a)
#pragma unroll
        for (int b = 0; b < 2; ++b)
#pragma unroll
            for (int m = 0; m < 4; ++m)
#pragma unroll
                for (int n = 0; n < 2; ++n) acc[a][b][m][n] = (f32x4){0.f, 0.f, 0.f, 0.f};
    bf16x8 At[4][2], B0[2][2], B1[2][2];
    const char* cA = PG8_ABASE(cur); const char* cB = (const char*)g.Bt + (size_t)cur.pn * tstep;
    S.a_ready(cur);
    if constexpr (SP2) {
        PG8_STAGE(PG8_SB(0, 0), cB, voffB); PG8_STAGE(PG8_SB(0, 1), cB + hstep, voffB); PG8_STAGE(PG8_SA(0, 0), cA, voffA); PG8_STAGE(PG8_SA(0, 1), cA + hstep, voffA);
        if (wr == 1) PG8_BAR;
        PG8_WAIT_V(2); PG8_BAR;
        PG8_STAGE(PG8_SB(1, 0), cB + kstep, voffB); PG8_STAGE(PG8_SA(1, 0), cA + kstep, voffA); PG8_STAGE(PG8_SB(1, 1), cB + hstep + kstep, voffB);
        PG8_WAIT_V(6); PG8_BAR;
    } else {
        PG8_STAGE(PG8_SB(0, 0), cB, voffB); PG8_STAGE(PG8_SA(0, 0), cA, voffA); PG8_STAGE(PG8_SB(0, 1), cB + hstep, voffB); PG8_STAGE(PG8_SA(0, 1), cA + hstep, voffA);
        if (wr == 1) PG8_BAR;
        PG8_WAIT_V(4); PG8_BAR;
        PG8_STAGE(PG8_SB(1, 0), cB + kstep, voffB); PG8_STAGE(PG8_SA(1, 0), cA + kstep, voffA); PG8_STAGE(PG8_SB(1, 1), cB + hstep + kstep, voffB);
        PG8_WAIT_V(6); PG8_BAR;
    }
    for (;;) {
        const bool has_next = S.next(ui + 1, nxt);
        const char* nA = has_next ? PG8_ABASE(nxt) : cA; const char* nB = has_next ? (const char*)g.Bt + (size_t)nxt.pn * tstep : cB;
        for (int t = 0; t < nt; t += 2) {
            const bool last = (t == nt - 2);
            const char* a1 = cA + (size_t)(t + 1) * kstep;
            const char* a2 = last ? nA : cA + (size_t)(t + 2) * kstep; const char* b2 = last ? nB : cB + (size_t)(t + 2) * kstep;
            const char* a3 = a2 + kstep; const char* b3 = b2 + kstep;
            if (last && has_next) S.a_ready(nxt);
            if constexpr (SP2) {
            PG8_LDB(B0, 0, 0); PG8_LDB(B1, 0, 1); PG8_SCHED; PG8_LDA(At, 0, 0); PG8_STAGE(PG8_SA(1, 1), a1 + hstep, voffA);
            PG8_WAIT_V(8); PG8_WAIT_L(0); PG8_BAR; PG8_MMA(0, 0, At, B0); PG8_MMA(0, 1, At, B1); PG8_BAR; PG8_SCHED;
            PG8_LDA(At, 0, 1); PG8_STAGE(PG8_SB(0, 0), b2, voffB); PG8_STAGE(PG8_SB(0, 1), b2 + hstep, voffB); PG8_STAGE(PG8_SA(0, 0), a2, voffA);
            PG8_WAIT_V(8); PG8_WAIT_L(0); PG8_BAR; PG8_MMA(1, 0, At, B0); PG8_MMA(1, 1, At, B1); PG8_BAR; PG8_SCHED;
            PG8_LDB(B0, 1, 0); PG8_LDB(B1, 1, 1); PG8_SCHED; PG8_LDA(At, 1, 0); PG8_STAGE(PG8_SA(0, 1), a2 + hstep, voffA);
            PG8_WAIT_V(8); PG8_WAIT_L(0); PG8_BAR; PG8_MMA(0, 0, At, B0); PG8_MMA(0, 1, At, B1); PG8_BAR; PG8_SCHED;
            PG8_LDA(At, 1, 1); PG8_STAGE(PG8_SB(1, 0), b3, voffB); PG8_STAGE(PG8_SB(1, 1), b3 + hstep, voffB); PG8_STAGE(PG8_SA(1, 0), a3, voffA);
            PG8_WAIT_V(8); PG8_WAIT_L(0); PG8_BAR; PG8_MMA(1, 0, At, B0); PG8_MMA(1, 1, At, B1); PG8_BAR; PG8_SCHED;
            } else {
            PG8_LDB(B0, 0, 0); PG8_SCHED; PG8_LDA(At, 0, 0); PG8_STAGE(PG8_SA(1, 1), a1 + hstep, voffA);
            PG8_WAIT_L(8); PG8_BAR; PG8_WAIT_L(0); PG8_MMA(0, 0, At, B0); PG8_BAR; PG8_SCHED;
            PG8_LDB(B1, 0, 1); PG8_STAGE(PG8_SB(0, 0), b2, voffB);
            PG8_BAR; PG8_WAIT_L(0); PG8_MMA(0, 1, At, B1); PG8_BAR;
            PG8_LDA(At, 0, 1); PG8_STAGE(PG8_SA(0, 0), a2, voffA);
            PG8_BAR; PG8_WAIT_L(0); PG8_MMA(1, 0, At, B0); PG8_BAR; PG8_SCHED;
            PG8_STAGE(PG8_SB(0, 1), b2 + hstep, voffB);
            PG8_WAIT_V(6); PG8_BAR; PG8_MMA(1, 1, At, B1); PG8_BAR;
            PG8_LDB(B0, 1, 0); PG8_SCHED; PG8_LDA(At, 1, 0); PG8_STAGE(PG8_SA(0, 1), a2 + hstep, voffA);
            PG8_WAIT_L(8); PG8_BAR; PG8_WAIT_L(0); PG8_MMA(0, 0, At, B0); PG8_BAR; PG8_SCHED;
            PG8_LDB(B1, 1, 1); PG8_STAGE(PG8_SB(1, 0), b3, voffB);
            PG8_BAR; PG8_WAIT_L(0); PG8_MMA(0, 1, At, B1); PG8_BAR;
            PG8_LDA(At, 1, 1); PG8_STAGE(PG8_SA(1, 0), a3, voffA);
            PG8_BAR; PG8_WAIT_L(0); PG8_MMA(1, 0, At, B0); PG8_BAR; PG8_SCHED;
            PG8_STAGE(PG8_SB(1, 1), b3 + hstep, voffB);
            PG8_WAIT_V(6); PG8_BAR; PG8_MMA(1, 1, At, B1); PG8_BAR;
            }
        }
        if constexpr (ALIGN_EPI) { if (wr == 0) PG8_BAR; }
        if constexpr (!Epi::AFTER_DRAIN) { E(acc, cur, wr, wc, fr, fq); S.done(cur); }
        if (!has_next) break;
#pragma unroll
        for (int a = 0; a < 2; ++a)
#pragma unroll
            for (int b = 0; b < 2; ++b)
#pragma unroll
                for (int m = 0; m < 4; ++m)
#pragma unroll
                    for (int n = 0; n < 2; ++n) acc[a][b][m][n] = (f32x4){0.f, 0.f, 0.f, 0.f};
        cur = nxt; cA = nA; cB = nB; ++ui;
        if constexpr (ALIGN_EPI) { if (wr == 1) PG8_BAR; }
    }
    PG8_WAIT_V(0);
    if constexpr (!ALIGN_EPI) { if (wr == 0) PG8_BAR; }
    PG8_BAR;
#undef PG8_SA
#undef PG8_SB
#undef PG8_STAGE
#undef PG8_LDA
#undef PG8_LDB
#undef PG8_MMA
#undef PG8_WAIT_V
#undef PG8_WAIT_L
#undef PG8_BAR
#undef PG8_SCHED
#undef PG8_ABASE
}
}

#define XB_TMO      128
#define XB_XCNT(j)  (256  + 64 * (j))
#define XB_XSUB(j)  (1280 + 64 * (j))
#define XB_XGEN(j)  (2304 + 64 * (j))
#define XB_TOP      3328
#define XB_TOPGEN   3392
#define XCD_BAR_WORDS 3456
#define XB_SPIN_CAP (1u << 18)
__device__ __forceinline__ unsigned xb_ld(unsigned* p)              { return __hip_atomic_load(p, __ATOMIC_RELAXED, __HIP_MEMORY_SCOPE_AGENT); }
__device__ __forceinline__ unsigned xb_add(unsigned* p, unsigned v) { return __hip_atomic_fetch_add(p, v, __ATOMIC_RELAXED, __HIP_MEMORY_SCOPE_AGENT); }
__device__ __forceinline__ unsigned xb_xcc_id() { return (unsigned)__builtin_amdgcn_s_getreg((3 << 11) | 20) & 0xFu; }
#define XB_SPIN(cond, bar) do { unsigned _sp = 0; while (cond) { __builtin_amdgcn_s_sleep(1); \
    if ((++_sp & 255u) == 0u) { if (xb_ld(&(bar)[XB_TMO])) break; if (_sp > XB_SPIN_CAP) { atomicAdd(&(bar)[XB_TMO], 1u); break; } } } } while (0)
struct XcdBarrier { unsigned* bar; unsigned x; volatile LAS unsigned* st; };
__device__ __forceinline__ XcdBarrier xcd_barrier_post(unsigned* bar, volatile LAS unsigned* st) {
    XcdBarrier b; b.bar = bar; b.x = xb_xcc_id(); b.st = st;
    if (threadIdx.x == 0) (void)xb_add(&bar[XB_XCNT(b.x)], 1u);
    return b;
}
__device__ __forceinline__ void xcd_barrier_complete(unsigned* bar, unsigned x, unsigned& nloc, unsigned& nx) {
    const unsigned G = gridDim.x * gridDim.y * gridDim.z;
    unsigned sum, cnt, mine, sp = 0u;
    for (;;) {
        sum = 0u; cnt = 0u; mine = 0u;
#pragma unroll
        for (unsigned j = 0; j < 16; ++j) { const unsigned c = xb_ld(&bar[XB_XCNT(j)]); sum += c; cnt += (c > 0u) ? 1u : 0u; mine = (j == x) ? c : mine; }
        if (sum == G) break;
        __builtin_amdgcn_s_sleep(1);
        if ((++sp & 255u) == 0u) { if (xb_ld(&bar[XB_TMO])) break; if (sp > XB_SPIN_CAP) { atomicAdd(&bar[XB_TMO], 1u); break; } }
    }
    nloc = mine > 0u ? mine : 1u; nx = cnt > 0u ? cnt : 1u;
}
__device__ __forceinline__ void xcd_barrier(const XcdBarrier& b) {
    asm volatile("s_waitcnt vmcnt(0)" ::: "memory");
    __syncthreads();
    if (threadIdx.x == 0) {
        unsigned* bar = b.bar;
        __builtin_amdgcn_s_waitcnt(0);
        unsigned nloc = b.st[0], nx = b.st[1];
        if (nloc == 0u) { xcd_barrier_complete(bar, b.x, nloc, nx); b.st[0] = nloc; b.st[1] = nx; }
        const unsigned old = xb_add(&bar[XB_XSUB(b.x)], 1u);
        const unsigned gen = old / nloc;
        if (old + 1u == (gen + 1u) * nloc) {
            __builtin_amdgcn_fence(__ATOMIC_RELEASE, "agent");
            asm volatile("s_waitcnt vmcnt(0)" ::: "memory");
            const unsigned og = xb_add(&bar[XB_TOP], 1u);
            const unsigned tg = og / nx;
            if (og + 1u == (tg + 1u) * nx) xb_add(&bar[XB_TOPGEN], 1u);
            else XB_SPIN(xb_ld(&bar[XB_TOPGEN]) == tg, bar);
            __builtin_amdgcn_fence(__ATOMIC_ACQUIRE, "agent");
            xb_add(&bar[XB_XGEN(b.x)], 1u);
            asm volatile("s_waitcnt vmcnt(0)" ::: "memory");
        } else {
            XB_SPIN(xb_ld(&bar[XB_XGEN(b.x)]) == gen, bar);
            __builtin_amdgcn_fence(__ATOMIC_ACQUIRE, "agent");
            asm volatile("s_waitcnt vmcnt(0)" ::: "memory");
        }
    }
    __syncthreads();
}

constexpr int NWAVES = 8, NTHREADS = 512;
constexpr int LDS_BYTES = 147456;
constexpr int RING_OFF = 0, RING_BYTES = 131072, LDSCTL_OFF = RING_BYTES, MISC_OFF = LDSCTL_OFF + 320;
constexpr int CW_TMO = 0, CW_BAR = 4096;
struct Args {
    const float* in[26]; float* out; unsigned char* ws; int ph_lo, ph_hi, perm_qk, li;
};
enum Phase { P_PRO = 0, P_NORM_A1, P_GEMM_IN, P_LRU1, P_LRU2, P_GEMM_OUT, P_NORM_A2, P_UP0, P_DN0, P_NORM_B, P_QKV, P_ATTN, P_GEMM_O, P_NORM_B2, P_UP1, P_DN1, P_COUNT };

struct Frame {
    LAS unsigned char* lds; int tid, lane, wave, G;
};

__device__ __forceinline__ int qk_perm_row(int n) { const int L = n & 255; return (n & ~255) + 128 * ((L >> 5) & 1) + 32 * (L >> 6) + (L & 31); }
__device__ __forceinline__ void p0_transpose_item(const float* Wsrc, int K, int N, bf16* WT, int row_off, int perm_below, LAS float* scr, int item, int lane) {
    const int nblk = N / 32, kb = item / nblk, nb = item % nblk, k0 = 64 * kb, n0 = 32 * nb;
#pragma unroll 8
    for (int i = 0; i < 32; ++i) { const int kk = 2 * i + (lane >> 5); scr[kk * 33 + (lane & 31)] = Wsrc[(size_t)(k0 + kk) * N + n0 + (lane & 31)]; }
    asm volatile("s_waitcnt lgkmcnt(0)" ::: "memory");
    const int c = lane & 7;
#pragma unroll
    for (int j = 0; j < 4; ++j) { const int n = (lane >> 3) + 8 * j; const LAS float* s = scr + (8 * c) * 33 + n;
        v4u o; o.x = pk2(s[0 * 33], s[1 * 33]); o.y = pk2(s[2 * 33], s[3 * 33]); o.z = pk2(s[4 * 33], s[5 * 33]); o.w = pk2(s[6 * 33], s[7 * 33]);
        int drow = row_off + n0 + n; if (drow < perm_below) drow = qk_perm_row(drow);
        *(GAS v4u*)(WT + (size_t)drow * K + k0 + 8 * c) = o; }
    asm volatile("s_waitcnt lgkmcnt(0)" ::: "memory");
}

__device__ __forceinline__ void p0_prologue(Frame& F, const Args& a) {
    unsigned char* ws = a.ws;
    {
        LAS float* cact = (LAS float*)(F.lds);
        LAS float* red = (LAS float*)(F.lds + 16384);
        const float* c = a.in[1];
        for (int i = F.tid; i < BATCH * D; i += NTHREADS) { const float v = c[i]; cact[i] = v / (1.f + __expf(-v)); }
        __syncthreads();
        for (int item = blockIdx.x; item < 224; item += F.G) {
            const int gc = item * 64; const float* Wp; const float* bp; float* op; int N, j0;
            if (gc < 6144) { Wp = a.in[2]; bp = a.in[3]; op = (float*)(ws + WS_MOD0); N = 6144; j0 = gc; }
            else if (gc < 12288) { Wp = a.in[2] + (size_t)D * 6144; bp = a.in[3] + 6144; op = (float*)(ws + WS_MOD1); N = 6144; j0 = gc - 6144; }
            else { Wp = a.in[18]; bp = a.in[19]; op = (float*)(ws + WS_KVMOD); N = 2048; j0 = gc - 12288; }
            float a0 = 0.f, a1 = 0.f, a2 = 0.f, a3 = 0.f;
            const int kbase = F.wave * 128;
            const float* wp = Wp + (size_t)kbase * N + j0 + F.lane;
#pragma unroll 8
            for (int k = 0; k < 128; ++k) { const float w = wp[(size_t)k * N]; const int kk = kbase + k;
                a0 += cact[kk] * w; a1 += cact[1024 + kk] * w; a2 += cact[2048 + kk] * w; a3 += cact[3072 + kk] * w; }
            red[(F.wave * 4 + 0) * 64 + F.lane] = a0; red[(F.wave * 4 + 1) * 64 + F.lane] = a1; red[(F.wave * 4 + 2) * 64 + F.lane] = a2; red[(F.wave * 4 + 3) * 64 + F.lane] = a3;
            __syncthreads();
            if (F.tid < 256) { const int b = F.tid >> 6, l = F.tid & 63; float s = 0.f;
#pragma unroll
                for (int w = 0; w < 8; ++w) s += red[(w * 4 + b) * 64 + l];
                op[(size_t)b * N + j0 + l] = s + bp[j0 + l]; }
            __syncthreads();
        }
    }
    {
        LAS float* scr = (LAS float*)(F.lds + 32768 + F.wave * 12288);
        const int gw = blockIdx.x * NWAVES + F.wave, NGW = F.G * NWAVES;
        constexpr int I_IN = (D / 64) * (2 * W / 32), I_OUT = (W / 64) * (D / 32), I_1 = (D / 64) * (FF / 32), I_2 = (FF / 64) * (D / 32), I_Q = (D / 64) * (D / 32), I_KV = (D / 64) * (2 * D / 32), I_O = I_Q;
        constexpr int NITEMS = I_IN + I_OUT + 2 * I_1 + 2 * I_2 + I_Q + I_KV + I_O;
        const int permq = a.perm_qk ? D : 0, permkv = a.perm_qk ? 2 * D : 0;
        for (int it = gw; it < NITEMS; it += NGW) {
            int r = it;
            if (r < I_IN) { p0_transpose_item(a.in[8], D, 2 * W, (bf16*)(ws + WS_WIN), 0, 0, scr, r, F.lane); continue; } r -= I_IN;
            if (r < I_OUT) { p0_transpose_item(a.in[16], W, D, (bf16*)(ws + WS_WOUT), 0, 0, scr, r, F.lane); continue; } r -= I_OUT;
            if (r < I_1) { p0_transpose_item(a.in[6], D, FF, (bf16*)(ws + WS_W1), 0, 0, scr, r, F.lane); continue; } r -= I_1;
            if (r < I_1) { p0_transpose_item(a.in[6] + (size_t)D * FF, D, FF, (bf16*)(ws + WS_W1) + (size_t)FF * D, 0, 0, scr, r, F.lane); continue; } r -= I_1;
            if (r < I_2) { p0_transpose_item(a.in[7], FF, D, (bf16*)(ws + WS_W2), 0, 0, scr, r, F.lane); continue; } r -= I_2;
            if (r < I_2) { p0_transpose_item(a.in[7] + (size_t)D * FF, FF, D, (bf16*)(ws + WS_W2) + (size_t)FF * D, 0, 0, scr, r, F.lane); continue; } r -= I_2;
            if (r < I_Q) { p0_transpose_item(a.in[22], D, D, (bf16*)(ws + WS_WQKV), 0, permq, scr, r, F.lane); continue; } r -= I_Q;
            if (r < I_KV) { p0_transpose_item(a.in[20], D, 2 * D, (bf16*)(ws + WS_WQKV), D, permkv, scr, r, F.lane); continue; } r -= I_KV;
            p0_transpose_item(a.in[25], D, D, (bf16*)(ws + WS_WO), 0, 0, scr, r, F.lane);
        }
    }
}

__device__ __forceinline__ void norm_rows(Frame& F, const float* src, const float* g, const float* shift, const float* scale, int mstride, bf16* dst,
                                          const float* g2, const float* shift2, const float* scale2, int mstride2, bf16* dst2) {
    const int gw = blockIdx.x * NWAVES + F.wave, NGW = F.G * NWAVES;
    for (int m = gw; m < M; m += NGW) {
        const int b = m / SEQ;
        const GAS f32x4* xr = (const GAS f32x4*)(src + (size_t)m * D) + F.lane;
        f32x4 v[4]; float s = 0.f;
#pragma unroll
        for (int j = 0; j < 4; ++j) { v[j] = xr[64 * j]; s += (v[j].x * v[j].x + v[j].y * v[j].y) + (v[j].z * v[j].z + v[j].w * v[j].w); }
        const float rstd = 1.f / sqrtf(wave_sum(s) * (1.f / D) + EPS);
        {
            const GAS f32x4* gp = (const GAS f32x4*)g + F.lane; const GAS f32x4* sh = (const GAS f32x4*)(shift + (size_t)b * mstride) + F.lane; const GAS f32x4* sc = (const GAS f32x4*)(scale + (size_t)b * mstride) + F.lane;
            GAS unsigned long long* o8 = (GAS unsigned long long*)(dst + (size_t)m * D) + F.lane;
#pragma unroll
            for (int j = 0; j < 4; ++j) { const f32x4 gg = gp[64 * j], hh = sh[64 * j], cc = sc[64 * j];
                const f32x4 y = (v[j] * rstd) * gg * (cc + 1.f) + hh;
                o8[64 * j] = (unsigned long long)pk2(y.x, y.y) | ((unsigned long long)pk2(y.z, y.w) << 32); }
        }
        if (dst2) {
            const GAS f32x4* gp = (const GAS f32x4*)g2 + F.lane; const GAS f32x4* sh = (const GAS f32x4*)(shift2 + (size_t)b * mstride2) + F.lane; const GAS f32x4* sc = (const GAS f32x4*)(scale2 + (size_t)b * mstride2) + F.lane;
            GAS unsigned long long* o8 = (GAS unsigned long long*)(dst2 + (size_t)m * D) + F.lane;
#pragma unroll
            for (int j = 0; j < 4; ++j) { const f32x4 gg = gp[64 * j], hh = sh[64 * j], cc = sc[64 * j];
                const f32x4 y = (v[j] * rstd) * gg * (cc + 1.f) + hh;
                o8[64 * j] = (unsigned long long)pk2(y.x, y.y) | ((unsigned long long)pk2(y.z, y.w) << 32); }
        }
    }
}

__global__ void __launch_bounds__(NTHREADS, 2) mk_fwd(Args args) {
    extern __shared__ __attribute__((aligned(16))) unsigned char lds[];
    Frame F; F.lds = (LAS unsigned char*)lds; F.tid = threadIdx.x; F.lane = F.tid & 63; F.wave = __builtin_amdgcn_readfirstlane(F.tid >> 6); F.G = gridDim.x;
    unsigned char* ws = args.ws;
    const int lo = args.ph_lo, hi = args.ph_hi;
    for (int u = F.tid; u < (LDS_BYTES - LDSCTL_OFF) / 4; u += NTHREADS) ((LAS unsigned*)(F.lds + LDSCTL_OFF))[u] = 0u;
    __syncthreads();
    unsigned* ctl = (unsigned*)(ws + WS_CTL);
    XcdBarrier bar; bar.bar = ctl + CW_BAR + args.li * XCD_BAR_WORDS; bar.x = 0; bar.st = nullptr;
    if (hi - lo > 1) bar = xcd_barrier_post(ctl + CW_BAR + args.li * XCD_BAR_WORDS, (volatile LAS unsigned*)(F.lds + MISC_OFF) + 8);
#define IN(k) (lo <= (k) && (k) < hi)
#define SEAM(k) do { if (IN(k) && IN((k) + 1)) xcd_barrier(bar); } while (0)
    float* mod0 = (float*)(ws + WS_MOD0); float* mod1 = (float*)(ws + WS_MOD1); float* kvmod = (float*)(ws + WS_KVMOD);
    bf16* HNA = (bf16*)(ws + WS_HNA); bf16* HNB = (bf16*)(ws + WS_HNB); bf16* YG = (bf16*)(ws + WS_YG); bf16* Z = (bf16*)(ws + WS_Z); bf16* HB = (bf16*)(ws + WS_BIG);
    bf16* Qb = (bf16*)(ws + WS_Q); bf16* Kb = (bf16*)(ws + WS_K); bf16* Vb = (bf16*)(ws + WS_V); bf16* Ob = (bf16*)(ws + WS_O);
    bf16* WIN = (bf16*)(ws + WS_WIN); bf16* WOUT = (bf16*)(ws + WS_WOUT); bf16* W1 = (bf16*)(ws + WS_W1); bf16* W2 = (bf16*)(ws + WS_W2); bf16* WQKV = (bf16*)(ws + WS_WQKV); bf16* WO = (bf16*)(ws + WS_WO);
    const int NOA2 = 1 << 30;

    if (IN(P_PRO)) { p0_prologue(F, args); } SEAM(P_PRO);
    if (IN(P_NORM_A1)) { norm_rows(F, args.in[0], args.in[4], mod0 + 0, mod0 + 1024, 6144, HNA, nullptr, nullptr, nullptr, 0, nullptr); } SEAM(P_NORM_A1);
    if (IN(P_GEMM_IN)) {
        pg8::Gemm g{HNA, HNA, NOA2, WIN, M, 2 * W, D}; pg8::StaticOrder S; S.init(M, 2 * W, F.G, (int)blockIdx.x);
        pg8::EpiBf16<0> E{Z, 2 * W};
        pg8::gemm_phase<pg8::EpiBf16<0>, pg8::StaticOrder, true, true>(F.lds + RING_OFF, g, S, E);
    } SEAM(P_GEMM_IN);
    SEAM(P_LRU1);
    SEAM(P_LRU2);
    if (IN(P_GEMM_OUT)) {
        pg8::Gemm g{YG, YG, NOA2, WOUT, M, D, W}; pg8::StaticOrder S; S.init(M, D, F.G, (int)blockIdx.x);
        pg8::EpiRes E{args.in[0], args.out, mod0 + 2048, 6144, SEQ};
        pg8::gemm_phase<pg8::EpiRes, pg8::StaticOrder, true, true>(F.lds + RING_OFF, g, S, E);
    } SEAM(P_GEMM_OUT);
    if (IN(P_NORM_A2)) { norm_rows(F, args.out, args.in[5], mod0 + 3072, mod0 + 4096, 6144, HNA, nullptr, nullptr, nullptr, 0, nullptr); } SEAM(P_NORM_A2);
    if (IN(P_UP0)) {
        pg8::Gemm g{HNA, HNA, NOA2, W1, M, FF, D}; pg8::StaticOrder S; S.init(M, FF, F.G, (int)blockIdx.x);
        pg8::EpiBf16<2> E{HB, FF};
        pg8::gemm_phase<pg8::EpiBf16<2>, pg8::StaticOrder, true, true>(F.lds + RING_OFF, g, S, E);
    } SEAM(P_UP0);
    if (IN(P_DN0)) {
        pg8::Gemm g{HB, HB, NOA2, W2, M, D, FF}; pg8::StaticOrder S; S.init(M, D, F.G, (int)blockIdx.x);
        pg8::EpiRes E{args.out, args.out, mod0 + 5120, 6144, SEQ};
        pg8::gemm_phase<pg8::EpiRes, pg8::StaticOrder, true, true>(F.lds + RING_OFF, g, S, E);
    } SEAM(P_DN0);
    if (IN(P_NORM_B)) { norm_rows(F, args.out, args.in[4] + D, mod1 + 0, mod1 + 1024, 6144, HNA, args.in[17], kvmod + 0, kvmod + 1024, 2048, HNB); } SEAM(P_NORM_B);
    if (IN(P_QKV)) {
        pg8::Gemm g{HNA, HNB, 4, WQKV, M, 3 * D, D}; pg8::StaticOrder S; S.init(M, 3 * D, F.G, (int)blockIdx.x);
        pg8::EpiQKV E{Qb, Kb, Vb, args.in[23], args.in[21], QSCALE, EPS};
        pg8::gemm_phase<pg8::EpiQKV, pg8::StaticOrder, true, true>(F.lds + RING_OFF, g, S, E);
    } SEAM(P_QKV);
    SEAM(P_ATTN);
    if (IN(P_GEMM_O)) {
        pg8::Gemm g{Ob, Ob, NOA2, WO, M, D, D}; pg8::StaticOrder S; S.init(M, D, F.G, (int)blockIdx.x);
        pg8::EpiRes E{args.out, args.out, mod1 + 2048, 6144, SEQ};
        pg8::gemm_phase<pg8::EpiRes, pg8::StaticOrder, true, true>(F.lds + RING_OFF, g, S, E);
    } SEAM(P_GEMM_O);
    if (IN(P_NORM_B2)) { norm_rows(F, args.out, args.in[5] + D, mod1 + 3072, mod1 + 4096, 6144, HNA, nullptr, nullptr, nullptr, 0, nullptr); } SEAM(P_NORM_B2);
    if (IN(P_UP1)) {
        pg8::Gemm g{HNA, HNA, NOA2, W1 + (size_t)FF * D, M, FF, D}; pg8::StaticOrder S; S.init(M, FF, F.G, (int)blockIdx.x);
        pg8::EpiBf16<2> E{HB, FF};
        pg8::gemm_phase<pg8::EpiBf16<2>, pg8::StaticOrder, true, true>(F.lds + RING_OFF, g, S, E);
    } SEAM(P_UP1);
    if (IN(P_DN1)) {
        pg8::Gemm g{HB, HB, NOA2, W2 + (size_t)FF * D, M, D, FF}; pg8::StaticOrder S; S.init(M, D, F.G, (int)blockIdx.x);
        pg8::EpiRes E{args.out, args.out, mod1 + 5120, 6144, SEQ};
        pg8::gemm_phase<pg8::EpiRes, pg8::StaticOrder, true, true>(F.lds + RING_OFF, g, S, E);
    }
#undef SEAM
#undef IN
}

struct NEpi {
    int mode;
    bf16* O; int ldc;
    const float* base; float* out; const float* gate; int gstride;
    const float* qg; const float* kg; bf16* Q; bf16* Kb; bf16* V;
};
__global__ void __launch_bounds__(256) naive_gemm(const bf16* A, const bf16* A2, int a2_from_col, const bf16* Bt, int N, int K, NEpi e) {
    __shared__ float As[32][65];
    __shared__ float Bs[32][65];
    __shared__ float red[64][17];
    const int t = threadIdx.x, tx = t & 15, ty = t >> 4;
    const int m0 = blockIdx.y * 64, n0 = blockIdx.x * 64;
    const bf16* Ause = (n0 >= a2_from_col) ? A2 : A;
    float acc[4][4];
#pragma unroll
    for (int i = 0; i < 4; ++i)
#pragma unroll
        for (int j = 0; j < 4; ++j) acc[i][j] = 0.f;
    const int lr = t >> 2, lc = t & 3;
    for (int k0 = 0; k0 < K; k0 += 32) {
        const v4u av = *(const v4u*)(Ause + (size_t)(m0 + lr) * K + k0 + lc * 8);
        const v4u bv = *(const v4u*)(Bt + (size_t)(n0 + lr) * K + k0 + lc * 8);
        __syncthreads();
        As[lc * 8 + 0][lr] = bf2f(av.x & 0xffffu); As[lc * 8 + 1][lr] = bf2f(av.x >> 16); As[lc * 8 + 2][lr] = bf2f(av.y & 0xffffu); As[lc * 8 + 3][lr] = bf2f(av.y >> 16);
        As[lc * 8 + 4][lr] = bf2f(av.z & 0xffffu); As[lc * 8 + 5][lr] = bf2f(av.z >> 16); As[lc * 8 + 6][lr] = bf2f(av.w & 0xffffu); As[lc * 8 + 7][lr] = bf2f(av.w >> 16);
        Bs[lc * 8 + 0][lr] = bf2f(bv.x & 0xffffu); Bs[lc * 8 + 1][lr] = bf2f(bv.x >> 16); Bs[lc * 8 + 2][lr] = bf2f(bv.y & 0xffffu); Bs[lc * 8 + 3][lr] = bf2f(bv.y >> 16);
        Bs[lc * 8 + 4][lr] = bf2f(bv.z & 0xffffu); Bs[lc * 8 + 5][lr] = bf2f(bv.z >> 16); Bs[lc * 8 + 6][lr] = bf2f(bv.w & 0xffffu); Bs[lc * 8 + 7][lr] = bf2f(bv.w >> 16);
        __syncthreads();
#pragma unroll
        for (int k = 0; k < 32; ++k) {
            float av4[4], bv4[4];
#pragma unroll
            for (int i = 0; i < 4; ++i) { av4[i] = As[k][ty * 4 + i]; bv4[i] = Bs[k][tx * 4 + i]; }
#pragma unroll
            for (int i = 0; i < 4; ++i)
#pragma unroll
                for (int j = 0; j < 4; ++j) acc[i][j] += av4[i] * bv4[j];
        }
    }
    if (e.mode == 0 || e.mode == 1) {
#pragma unroll
        for (int i = 0; i < 4; ++i) { const int row = m0 + ty * 4 + i;
#pragma unroll
            for (int j = 0; j < 4; ++j) { float v = acc[i][j]; if (e.mode == 1) { v = v > 0.f ? v : 0.f; v = v * v; }
                e.O[(size_t)row * e.ldc + n0 + tx * 4 + j] = (bf16)f2bf(v); } }
    } else if (e.mode == 2) {
#pragma unroll
        for (int i = 0; i < 4; ++i) { const int row = m0 + ty * 4 + i; const int b = row / SEQ;
#pragma unroll
            for (int j = 0; j < 4; ++j) { const int col = n0 + tx * 4 + j;
                e.out[(size_t)row * D + col] = e.base[(size_t)row * D + col] + e.gate[(size_t)b * e.gstride + col] * acc[i][j]; } }
    } else {
        const int tsel = n0 / D, cbase = n0 % D;
        bf16* dst = tsel == 0 ? e.Q : (tsel == 1 ? e.Kb : e.V);
        float rs[4] = {1.f, 1.f, 1.f, 1.f};
        if (tsel < 2) {
#pragma unroll
            for (int i = 0; i < 4; ++i) { float p = 0.f;
#pragma unroll
                for (int j = 0; j < 4; ++j) p += acc[i][j] * acc[i][j];
                red[ty * 4 + i][tx] = p; }
            __syncthreads();
#pragma unroll
            for (int i = 0; i < 4; ++i) { float s = 0.f;
                for (int x = 0; x < 16; ++x) s += red[ty * 4 + i][x];
                rs[i] = 1.f / sqrtf(s * (1.f / HD) + EPS); }
        }
#pragma unroll
        for (int i = 0; i < 4; ++i) { const int row = m0 + ty * 4 + i;
#pragma unroll
            for (int j = 0; j < 4; ++j) { const int d = tx * 4 + j; float v = acc[i][j];
                if (tsel == 0) v = v * rs[i] * e.qg[d] * QSCALE; else if (tsel == 1) v = v * rs[i] * e.kg[d];
                dst[(size_t)row * D + cbase + d] = (bf16)f2bf(v); } }
    }
}

__global__ void __launch_bounds__(128) naive_lru(const bf16* Z, const float* conv_w, const float* conv_b, const float* wa, const float* ba, const float* wx, const float* bx, const float* lam, bf16* YG) {
    __shared__ float swa[LB * LB];
    __shared__ float swx[LB * LB];
    __shared__ float xcs[LB];
    const int b = blockIdx.x / NLB, n = blockIdx.x % NLB, e = threadIdx.x;
    for (int i = e; i < LB * LB; i += 128) { swa[i] = wa[(size_t)n * LB * LB + i]; swx[i] = wx[(size_t)n * LB * LB + i]; }
    const int ch = n * LB + (e < LB ? e : 0);
    const float cw0 = conv_w[0 * W + ch], cw1 = conv_w[1 * W + ch], cw2 = conv_w[2 * W + ch], cw3 = conv_w[3 * W + ch], cb = conv_b[ch];
    const float bav = ba[ch], bxv = bx[ch];
    const float sp = log1pf(__expf(-lam[ch]));
    float x0 = 0.f, x1 = 0.f, x2 = 0.f, h = 0.f;
    __syncthreads();
    for (int t = 0; t < SEQ; ++t) {
        const size_t row = (size_t)b * SEQ + t;
        const float x3 = bf2f(Z[row * (2 * W) + W + ch]);
        const float gt = bf2f(Z[row * (2 * W) + ch]);
        const float xc = cb + cw0 * x0 + cw1 * x1 + cw2 * x2 + cw3 * x3;
        x0 = x1; x1 = x2; x2 = x3;
        if (e < LB) xcs[e] = xc;
        __syncthreads();
        if (e < LB) {
            float pa = bav, px = bxv;
            for (int d = 0; d < LB; ++d) { const float xd = xcs[d]; pa += xd * swa[d * LB + e]; px += xd * swx[d * LB + e]; }
            const float r = sigmoidf_(pa), ig = sigmoidf_(px);
            const float la = -8.f * r * sp;
            const float av = __expf(la);
            const float mult = sqrtf(-expm1f(2.f * la));
            h = av * h + mult * (ig * xc);
            YG[row * W + ch] = (bf16)f2bf(h * gelu_tanh(gt));
        }
        __syncthreads();
    }
}

__global__ void __launch_bounds__(64) naive_attn(const bf16* Q, const bf16* Kb, const bf16* V, const float* rel_bias, bf16* O) {
    const int ci = blockIdx.x % (SEQ / CHUNK), h = (blockIdx.x / (SEQ / CHUNK)) % H, b = blockIdx.x / (SEQ / CHUNK * H);
    const int qi = threadIdx.x, qpos = ci * CHUNK + qi;
    const size_t qrow = (size_t)b * SEQ + qpos;
    float q[HD];
#pragma unroll
    for (int d = 0; d < HD; ++d) q[d] = bf2f(Q[qrow * D + h * HD + d]);
    const int k_lo = (ci - LEFT) * CHUNK < 0 ? 0 : (ci - LEFT) * CHUNK, k_hi = (ci + 1) * CHUNK;
    const float* rb = rel_bias + h * 257;
    float mx = -1e30f;
    for (int kp = k_lo; kp < k_hi; ++kp) {
        const v4u* kr = (const v4u*)(Kb + ((size_t)b * SEQ + kp) * D + h * HD); float s = 0.f;
#pragma unroll
        for (int c = 0; c < 8; ++c) { const v4u kv = kr[c];
            s += q[8 * c + 0] * bf2f(kv.x & 0xffffu) + q[8 * c + 1] * bf2f(kv.x >> 16) + q[8 * c + 2] * bf2f(kv.y & 0xffffu) + q[8 * c + 3] * bf2f(kv.y >> 16)
               + q[8 * c + 4] * bf2f(kv.z & 0xffffu) + q[8 * c + 5] * bf2f(kv.z >> 16) + q[8 * c + 6] * bf2f(kv.w & 0xffffu) + q[8 * c + 7] * bf2f(kv.w >> 16); }
        int rel = qpos - kp; rel = rel < -128 ? -128 : (rel > 128 ? 128 : rel);
        s += rb[rel + 128] * LOG2E;
        mx = s > mx ? s : mx;
    }
    float o[HD]; float l = 0.f;
#pragma unroll
    for (int d = 0; d < HD; ++d) o[d] = 0.f;
    for (int kp = k_lo; kp < k_hi; ++kp) {
        const v4u* kr = (const v4u*)(Kb + ((size_t)b * SEQ + kp) * D + h * HD); float s = 0.f;
#pragma unroll
        for (int c = 0; c < 8; ++c) { const v4u kv = kr[c];
            s += q[8 * c + 0] * bf2f(kv.x & 0xffffu) + q[8 * c + 1] * bf2f(kv.x >> 16) + q[8 * c + 2] * bf2f(kv.y & 0xffffu) + q[8 * c + 3] * bf2f(kv.y >> 16)
               + q[8 * c + 4] * bf2f(kv.z & 0xffffu) + q[8 * c + 5] * bf2f(kv.z >> 16) + q[8 * c + 6] * bf2f(kv.w & 0xffffu) + q[8 * c + 7] * bf2f(kv.w >> 16); }
        int rel = qpos - kp; rel = rel < -128 ? -128 : (rel > 128 ? 128 : rel);
        s += rb[rel + 128] * LOG2E;
        const float p = exp2f(s - mx); l += p;
        const v4u* vr = (const v4u*)(V + ((size_t)b * SEQ + kp) * D + h * HD);
#pragma unroll
        for (int c = 0; c < 8; ++c) { const v4u vv = vr[c];
            o[8 * c + 0] += p * bf2f(vv.x & 0xffffu); o[8 * c + 1] += p * bf2f(vv.x >> 16); o[8 * c + 2] += p * bf2f(vv.y & 0xffffu); o[8 * c + 3] += p * bf2f(vv.y >> 16);
            o[8 * c + 4] += p * bf2f(vv.z & 0xffffu); o[8 * c + 5] += p * bf2f(vv.z >> 16); o[8 * c + 6] += p * bf2f(vv.w & 0xffffu); o[8 * c + 7] += p * bf2f(vv.w >> 16); }
    }
    const float il = 1.f / l;
#pragma unroll
    for (int d = 0; d < HD; ++d) O[qrow * D + h * HD + d] = (bf16)f2bf(o[d] * il);
}

#ifndef FAST_GEMM
#define FAST_GEMM 1
#endif
extern "C" void kernel_launch(void* const* d_in, const int* in_sizes, int n_in, void* d_out, int out_size, void* d_ws, size_t ws_size, hipStream_t stream) {
    static int grid = 0;
    if (grid == 0) {
        if (n_in != 26 || out_size != M * D || ws_size < WS_END) { fprintf(stderr, "kernel_launch: unexpected shapes (n_in %d out %d ws %zu)\n", n_in, out_size, ws_size); grid = -1; return; }
        int dev = 0, cus = 0;
        if (hipGetDevice(&dev) != hipSuccess || hipDeviceGetAttribute(&cus, hipDeviceAttributeMultiprocessorCount, dev) != hipSuccess) { grid = -1; return; }
        if (hipFuncSetAttribute((const void*)mk_fwd, hipFuncAttributeMaxDynamicSharedMemorySize, LDS_BYTES) != hipSuccess) { fprintf(stderr, "kernel_launch: hipFuncSetAttribute failed\n"); grid = -1; return; }
        (void)hipGetLastError();
        grid = cus;
    }
    if (grid < 0) return;
    unsigned char* ws = (unsigned char*)d_ws;
    (void)hipMemsetAsync(ws + WS_CTL, 0, CTL_ZERO_BYTES, stream);
    Args a{};
    for (int i = 0; i < 26; ++i) a.in[i] = (const float*)d_in[i];
    a.out = (float*)d_out; a.ws = ws; a.perm_qk = 0;
    float* out = (float*)d_out; const float* x = (const float*)d_in[0];
    float* mod0 = (float*)(ws + WS_MOD0); float* mod1 = (float*)(ws + WS_MOD1);
    bf16* HNA = (bf16*)(ws + WS_HNA); bf16* HNB = (bf16*)(ws + WS_HNB); bf16* YG = (bf16*)(ws + WS_YG); bf16* Z = (bf16*)(ws + WS_Z); bf16* HB = (bf16*)(ws + WS_BIG);
    bf16* Qb = (bf16*)(ws + WS_Q); bf16* Kb = (bf16*)(ws + WS_K); bf16* Vb = (bf16*)(ws + WS_V); bf16* Ob = (bf16*)(ws + WS_O);
    bf16* WIN = (bf16*)(ws + WS_WIN); bf16* WOUT = (bf16*)(ws + WS_WOUT); bf16* W1 = (bf16*)(ws + WS_W1); bf16* W2 = (bf16*)(ws + WS_W2); bf16* WQKV = (bf16*)(ws + WS_WQKV); bf16* WO = (bf16*)(ws + WS_WO);
    int nli = 0;
    auto mk2 = [&](int p0, int p1) { a.ph_lo = p0; a.ph_hi = p1; a.li = nli++; hipLaunchKernelGGL(mk_fwd, dim3(grid), dim3(NTHREADS), LDS_BYTES, stream, a); };
    auto mk = [&](int p) { mk2(p, p + 1); };
    auto gemm = [&](const bf16* A, const bf16* A2, int a2col, const bf16* Bt, int N, int K, NEpi e) { hipLaunchKernelGGL(naive_gemm, dim3(N / 64, M / 64), dim3(256), 0, stream, A, A2, a2col, Bt, N, K, e); };
    a.perm_qk = FAST_GEMM ? 1 : 0;
    mk2(P_PRO, P_NORM_A1 + 1);
    if (FAST_GEMM) mk(P_GEMM_IN); else { NEpi e{}; e.mode = 0; e.O = Z; e.ldc = 2 * W; gemm(HNA, HNA, 1 << 30, WIN, 2 * W, D, e); }
    hipLaunchKernelGGL(naive_lru, dim3(BATCH * NLB), dim3(128), 0, stream, Z, (const float*)d_in[9], (const float*)d_in[10], (const float*)d_in[11], (const float*)d_in[12], (const float*)d_in[13], (const float*)d_in[14], (const float*)d_in[15], YG);
    if (FAST_GEMM) mk2(P_GEMM_OUT, P_DN0 + 1 + 1);
    else {
        { NEpi e{}; e.mode = 2; e.base = x; e.out = out; e.gate = mod0 + 2048; e.gstride = 6144; gemm(YG, YG, 1 << 30, WOUT, D, W, e); }
        mk(P_NORM_A2);
        { NEpi e{}; e.mode = 1; e.O = HB; e.ldc = FF; gemm(HNA, HNA, 1 << 30, W1, FF, D, e); }
        { NEpi e{}; e.mode = 2; e.base = out; e.out = out; e.gate = mod0 + 5120; e.gstride = 6144; gemm(HB, HB, 1 << 30, W2, D, FF, e); }
        mk(P_NORM_B);
    }
    if (FAST_GEMM) mk(P_QKV); else { NEpi e{}; e.mode = 3; e.qg = (const float*)d_in[23]; e.kg = (const float*)d_in[21]; e.Q = Qb; e.Kb = Kb; e.V = Vb; gemm(HNA, HNB, D, WQKV, 3 * D, D, e); }
    hipLaunchKernelGGL(naive_attn, dim3(BATCH * H * (SEQ / CHUNK)), dim3(64), 0, stream, Qb, Kb, Vb, (const float*)d_in[24], Ob);
    if (FAST_GEMM) mk2(P_GEMM_O, P_DN1 + 1);
    else {
        { NEpi e{}; e.mode = 2; e.base = out; e.out = out; e.gate = mod1 + 2048; e.gstride = 6144; gemm(Ob, Ob, 1 << 30, WO, D, D, e); }
        mk(P_NORM_B2);
        { NEpi e{}; e.mode = 1; e.O = HB; e.ldc = FF; gemm(HNA, HNA, 1 << 30, W1 + (size_t)FF * D, FF, D, e); }
        { NEpi e{}; e.mode = 2; e.base = out; e.out = out; e.gate = mod1 + 5120; e.gstride = 6144; gemm(HB, HB, 1 << 30, W2 + (size_t)FF * D, D, FF, e); }
    }
}
```

```cpp
#include <hip/hip_runtime.h>
#include <cstdio>
#include <cstdint>

#define GAS __attribute__((address_space(1)))
#define LAS __attribute__((address_space(3)))
typedef unsigned short bf16;
typedef unsigned v4u __attribute__((ext_vector_type(4)));
typedef float f32x4 __attribute__((ext_vector_type(4)));

constexpr int BATCH = 4, SEQ = 4096, D = 1024, M = BATCH * SEQ;
constexpr int W = 1408, NLB = 16, LB = 88, FF = 4096, H = 16, HD = 64, CHUNK = 64, LEFT = 8;
constexpr float EPS = 1e-6f;
constexpr float QSCALE = 0.125f * 1.4426950408889634f;
constexpr float LOG2E = 1.4426950408889634f;

constexpr size_t MiB = 1u << 20;
constexpr size_t WS_CTL = 0, CTL_ZERO_BYTES = 1 * MiB;
constexpr size_t WS_MOD0 = 1 * MiB, WS_MOD1 = WS_MOD0 + 4 * 6144 * 4, WS_KVMOD = WS_MOD1 + 4 * 6144 * 4;
constexpr size_t WS_LRUA = 2 * MiB, WS_LRUH = WS_LRUA + (size_t)BATCH * 64 * W * 4;
constexpr size_t WS_WIN = 8 * MiB;
constexpr size_t WS_WOUT = WS_WIN + (size_t)2 * W * D * 2;
constexpr size_t WS_W1 = WS_WOUT + (size_t)D * W * 2;
constexpr size_t WS_W2 = WS_W1 + (size_t)2 * FF * D * 2;
constexpr size_t WS_WQKV = WS_W2 + (size_t)2 * FF * D * 2;
constexpr size_t WS_WO = WS_WQKV + (size_t)3 * D * D * 2;
constexpr size_t WS_WEND = WS_WO + (size_t)D * D * 2;
constexpr size_t WS_HNA = 58 * MiB;
constexpr size_t WS_YG = 90 * MiB;
constexpr size_t WS_HNB = WS_YG;
constexpr size_t WS_BIG = 128 * MiB;
constexpr size_t WS_Z = WS_BIG + 8 * MiB;
constexpr size_t WS_Q = WS_BIG, WS_K = WS_BIG + 32 * MiB, WS_V = WS_BIG + 64 * MiB, WS_O = WS_BIG + 96 * MiB;
constexpr size_t WS_END = 256 * MiB;
static_assert(WS_WEND <= WS_HNA && WS_LRUH + (size_t)BATCH * 64 * W * 4 <= WS_WIN && WS_YG + (size_t)M * W * 2 <= WS_Z && WS_Z + (size_t)M * 2 * W * 2 <= WS_END, "ws map");

__device__ __forceinline__ unsigned f2bf(float f) { unsigned u = __builtin_bit_cast(unsigned, f); return (u + 0x7fffu + ((u >> 16) & 1u)) >> 16; }
__device__ __forceinline__ unsigned pk2(float lo, float hi) { return f2bf(lo) | (f2bf(hi) << 16); }
__device__ __forceinline__ float bf2f(unsigned h) { return __builtin_bit_cast(float, h << 16); }
__device__ __forceinline__ float wave_sum(float v) {
#pragma unroll
    for (int o = 1; o < 64; o <<= 1) v += __shfl_xor(v, o);
    return v;
}
__device__ __forceinline__ float sigmoidf_(float x) { return 1.f / (1.f + __expf(-x)); }
__device__ __forceinline__ float gelu_tanh(float x) { const float u = 0.7978845608028654f * (x + 0.044715f * x * x * x); return 0.5f * x * (1.f + tanhf(u)); }


namespace pg8 {
#define PG8_LAS __attribute__((address_space(3)))
typedef unsigned short bf16_t;
typedef short bf16x8 __attribute__((ext_vector_type(8)));
typedef float f32x4 __attribute__((ext_vector_type(4)));
typedef unsigned u32x4 __attribute__((ext_vector_type(4)));
constexpr int BM = 256, BK = 64, HALF = 128, HTB = HALF * BK * 2, STAGE_BYTES = 8 * HTB, NXCD = 8, WGM = 8;
__host__ __device__ __forceinline__ int lds_byte(int r, int c) { const int st = (r >> 4) * 2 + (c >> 5), rr = r & 15, cc = c & 31, ob = rr * 64 + cc * 2; return st * 1024 + (ob ^ (((ob >> 9) & 1) << 5)); }
__host__ __device__ __forceinline__ void stage_rc(int b, int& R, int& C) { const int st = b / 1024, sb = b % 1024, swz = sb ^ (((sb >> 9) & 1) << 5); R = (st >> 1) * 16 + swz / 64; C = (st & 1) * 32 + (swz % 64) / 2; }
__host__ __device__ __forceinline__ int perm32(int rho) { const int n = rho >> 4, i = rho & 15; return 8 * (i >> 2) + 4 * n + (i & 3); }
struct Unit { int pm, pn; };
struct Gemm { const bf16_t* A; const bf16_t* A2; int a2_pn; const bf16_t* Bt; int M, N, K; };
struct StaticOrder {
    int nM, nN, nwg, G, c;
    __host__ __device__ void init(int M, int N, int G_, int c_) { nM = M / BM; nN = N / BM; nwg = nM * nN; G = G_; c = c_; }
    __host__ __device__ bool next(int i, Unit& u) const {
        const long L = (long)i * G + c; if (L >= nwg) return false;
        int wgid = (int)L; { const int q = nwg / NXCD, r = nwg % NXCD, xcd = wgid % NXCD, off = wgid / NXCD; wgid = (xcd < r ? xcd * (q + 1) : r * (q + 1) + (xcd - r) * q) + off; }
        const int nig = WGM * nN, gid = wgid / nig, fm = gid * WGM, gsz = (nM - fm) < WGM ? (nM - fm) : WGM;
        u.pm = fm + ((wgid % nig) % gsz); u.pn = (wgid % nig) / gsz; return true;
    }
    __device__ __forceinline__ void a_ready(const Unit&) const {}
    __device__ __forceinline__ void done(const Unit&) const {}
};
__device__ __forceinline__ unsigned cvt_pk_bf16(float lo, float hi) { unsigned r; asm volatile("v_cvt_pk_bf16_f32 %0, %1, %2" : "=v"(r) : "v"(lo), "v"(hi)); return r; }

template <int ACT  > struct EpiBf16 {
    static constexpr bool PERM = true, AFTER_DRAIN = false;
    bf16_t* O; int ldc;
    __device__ __forceinline__ void operator()(const f32x4 (&acc)[2][2][4][2], const Unit& u, int wr, int wc, int fr, int fq) const {
        const int row0 = u.pm * BM + wr * 64 + fr; const int col0 = u.pn * BM + wc * 32 + 8 * fq;
#pragma unroll
        for (int ai = 0; ai < 2; ++ai)
#pragma unroll
            for (int m = 0; m < 4; ++m) { bf16_t* rowp = O + (size_t)(row0 + ai * HALF + m * 16) * ldc + col0;
#pragma unroll
                for (int bj = 0; bj < 2; ++bj) { f32x4 v0 = acc[ai][bj][m][0], v1 = acc[ai][bj][m][1];
                    if (ACT == 2) {
#pragma unroll
                        for (int e = 0; e < 4; ++e) { const float a = v0[e] > 0.f ? v0[e] : 0.f, b = v1[e] > 0.f ? v1[e] : 0.f; v0[e] = a * a; v1[e] = b * b; } }
                    u32x4 w; w.x = cvt_pk_bf16(v0[0], v0[1]); w.y = cvt_pk_bf16(v0[2], v0[3]); w.z = cvt_pk_bf16(v1[0], v1[1]); w.w = cvt_pk_bf16(v1[2], v1[3]);
                    *(u32x4*)(rowp + bj * HALF) = w; } }
    }
};
struct EpiQKV {
    static constexpr bool PERM = true, AFTER_DRAIN = false;
    bf16_t* Q; bf16_t* K; bf16_t* V; const float* qg; const float* kg; float qscale, eps;
    __device__ __forceinline__ void operator()(const f32x4 (&acc)[2][2][4][2], const Unit& u, int wr, int wc, int fr, int fq) const {
        const int row0 = u.pm * BM + wr * 64 + fr; const int tsel = u.pn >> 2, ct = (u.pn & 3) * BM;
        if (tsel == 2) {
            const int col0 = ct + wc * 32 + 8 * fq;
#pragma unroll
            for (int ai = 0; ai < 2; ++ai)
#pragma unroll
                for (int m = 0; m < 4; ++m) { bf16_t* rowp = V + (size_t)(row0 + ai * HALF + m * 16) * 1024 + col0;
#pragma unroll
                    for (int bj = 0; bj < 2; ++bj) { const f32x4 v0 = acc[ai][bj][m][0], v1 = acc[ai][bj][m][1];
                        u32x4 w; w.x = cvt_pk_bf16(v0[0], v0[1]); w.y = cvt_pk_bf16(v0[2], v0[3]); w.z = cvt_pk_bf16(v1[0], v1[1]); w.w = cvt_pk_bf16(v1[2], v1[3]);
                        *(u32x4*)(rowp + bj * HALF) = w; } }
        } else {
            bf16_t* dst = tsel == 0 ? Q : K; const float* g = tsel == 0 ? qg : kg; const float sc = tsel == 0 ? qscale : 1.f;
            f32x4 gv[2][2];
#pragma unroll
            for (int bj = 0; bj < 2; ++bj)
#pragma unroll
                for (int n = 0; n < 2; ++n) gv[bj][n] = *(const f32x4*)(g + 32 * bj + 8 * fq + 4 * n) * sc;
            const int col0 = ct + 64 * wc + 8 * fq;
#pragma unroll
            for (int ai = 0; ai < 2; ++ai)
#pragma unroll
                for (int m = 0; m < 4; ++m) {
                    float s = 0.f;
#pragma unroll
                    for (int bj = 0; bj < 2; ++bj)
#pragma unroll
                        for (int n = 0; n < 2; ++n) { const f32x4 x = acc[ai][bj][m][n]; s += (x[0] * x[0] + x[1] * x[1]) + (x[2] * x[2] + x[3] * x[3]); }
                    s += __shfl_xor(s, 16); s += __shfl_xor(s, 32);
                    const float rstd = 1.0f / sqrtf(s * (1.0f / 64.0f) + eps);
                    bf16_t* rowp = dst + (size_t)(row0 + ai * HALF + m * 16) * 1024 + col0;
#pragma unroll
                    for (int bj = 0; bj < 2; ++bj) { const f32x4 v0 = acc[ai][bj][m][0] * rstd * gv[bj][0], v1 = acc[ai][bj][m][1] * rstd * gv[bj][1];
                        u32x4 w; w.x = cvt_pk_bf16(v0[0], v0[1]); w.y = cvt_pk_bf16(v0[2], v0[3]); w.z = cvt_pk_bf16(v1[0], v1[1]); w.w = cvt_pk_bf16(v1[2], v1[3]);
                        *(u32x4*)(rowp + bj * 32) = w; } }
        }
    }
};
struct EpiRes {
    static constexpr bool PERM = false, AFTER_DRAIN = false;
    const float* base; float* out; const float* gate; int gstride, rows_per_batch;
    __device__ __forceinline__ void operator()(const f32x4 (&acc)[2][2][4][2], const Unit& u, int wr, int wc, int fr, int fq) const {
        const int b = (u.pm * BM) / rows_per_batch; const int col0 = u.pn * BM + wc * 32 + 4 * fq;
        f32x4 gv[2][2];
#pragma unroll
        for (int bj = 0; bj < 2; ++bj)
#pragma unroll
            for (int n = 0; n < 2; ++n) gv[bj][n] = *(const f32x4*)(gate + (size_t)b * gstride + col0 + bj * HALF + n * 16);
#pragma unroll
        for (int ai = 0; ai < 2; ++ai)
#pragma unroll
            for (int m = 0; m < 4; ++m) { const size_t off = (size_t)(u.pm * BM + ai * HALF + wr * 64 + m * 16 + fr) * 1024 + col0;
#pragma unroll
                for (int bj = 0; bj < 2; ++bj)
#pragma unroll
                    for (int n = 0; n < 2; ++n) { const f32x4 bs = *(const f32x4*)(base + off + bj * HALF + n * 16);
                        *(f32x4*)(out + off + bj * HALF + n * 16) = bs + gv[bj][n] * acc[ai][bj][m][n]; }
                if (m & 1) asm volatile("" ::: "memory"); }
    }
};

template <class Epi, class Sched, bool ALIGN_EPI = false, bool SP2 = false>
__device__ __forceinline__ void gemm_phase(PG8_LAS unsigned char* lds, const Gemm g, const Sched& S, const Epi& E) {
    const int tid = threadIdx.x, wid = __builtin_amdgcn_readfirstlane(tid >> 6), lane = tid & 63, wr = wid >> 2, wc = wid & 3, fr = lane & 15, fq = lane >> 4;
    const int K = g.K, nt = K / BK;
    unsigned voffA[2], voffB[2];
#pragma unroll
    for (int i = 0; i < 2; ++i) { int R, C; stage_rc(tid * 16 + i * 8192, R, C); const int Rb = Epi::PERM ? ((R & ~31) + perm32(R & 31)) : R;
        voffA[i] = (unsigned)(R * K + C) * 2u; voffB[i] = (unsigned)(Rb * K + C) * 2u; }
    const size_t kstep = (size_t)(BK * 2);
    const size_t hstep = (size_t)HALF * K * 2;
    const size_t tstep = 2 * hstep;
    const unsigned ldsw = (unsigned)wid * 1024u;
    const int aoff = lds_byte(wr * 64 + fr, fq * 8), boff = lds_byte(wc * 32 + fr, fq * 8);
#define PG8_SA(b, h) (((b) * 2 + (h)) * HTB)
#define PG8_SB(b, h) ((4 + (b) * 2 + (h)) * HTB)
#define PG8_STAGE(bufoff, gbase, voff) do { _Pragma("unroll") for (int _i = 0; _i < 2; ++_i) \
        __builtin_amdgcn_global_load_lds((const unsigned*)((const char*)(gbase) + (voff)[_i]), (PG8_LAS unsigned*)(lds + (bufoff) + ldsw + _i * 8192), 16, 0, 0); } while (0)
#define PG8_LDA(dst, b, h) do { _Pragma("unroll") for (int m = 0; m < 4; ++m) _Pragma("unroll") for (int k = 0; k < 2; ++k) dst[m][k] = *(const PG8_LAS bf16x8*)(lds + PG8_SA(b, h) + aoff + m * 2048 + k * 1024); } while (0)
#define PG8_LDB(dst, b, h) do { _Pragma("unroll") for (int n = 0; n < 2; ++n) _Pragma("unroll") for (int k = 0; k < 2; ++k) dst[n][k] = *(const PG8_LAS bf16x8*)(lds + PG8_SB(b, h) + boff + n * 2048 + k * 1024); } while (0)
#define PG8_MMA(ai, bj, At, Bt) do { __builtin_amdgcn_s_setprio(1); _Pragma("unroll") for (int m = 0; m < 4; ++m) _Pragma("unroll") for (int n = 0; n < 2; ++n) _Pragma("unroll") for (int k = 0; k < 2; ++k) \
        acc[ai][bj][m][n] = __builtin_amdgcn_mfma_f32_16x16x32_bf16(Bt[n][k], At[m][k], acc[ai][bj][m][n], 0, 0, 0); __builtin_amdgcn_s_setprio(0); } while (0)
#define PG8_WAIT_V(n) asm volatile("s_waitcnt vmcnt(" #n ")" ::: "memory")
#define PG8_WAIT_L(n) asm volatile("s_waitcnt lgkmcnt(" #n ")" ::: "memory")
#define PG8_BAR __builtin_amdgcn_s_barrier()
#define PG8_SCHED __builtin_amdgcn_sched_barrier(0)
#define PG8_ABASE(u) ((const char*)((u).pn >= g.a2_pn ? g.A2 : g.A) + (size_t)(u).pm * tstep)
    Unit cur, nxt; int ui = 0;
    if (!S.next(0, cur)) return;
    f32x4 acc[2][2][4][2];
#pragma unroll
    for (int a = 0; a < 2; ++a)
#pragma unroll
        for (int b = 0; b < 2; ++b)
#pragma unroll
            for (int m = 0; m < 4; ++m)
#pragma unroll
                for (int n = 0; n < 2; ++n) acc[a][b][m][n] = (f32x4){0.f, 0.f, 0.f, 0.f};
    bf16x8 At[4][2], B0[2][2], B1[2][2];
    const char* cA = PG8_ABASE(cur); const char* cB = (const char*)g.Bt + (size_t)cur.pn * tstep;
    S.a_ready(cur);
    if constexpr (SP2) {
        PG8_STAGE(PG8_SB(0, 0), cB, voffB); PG8_STAGE(PG8_SB(0, 1), cB + hstep, voffB); PG8_STAGE(PG8_SA(0, 0), cA, voffA); PG8_STAGE(PG8_SA(0, 1), cA + hstep, voffA);
        if (wr == 1) PG8_BAR;
        PG8_WAIT_V(2); PG8_BAR;
        PG8_STAGE(PG8_SB(1, 0), cB + kstep, voffB); PG8_STAGE(PG8_SA(1, 0), cA + kstep, voffA); PG8_STAGE(PG8_SB(1, 1), cB + hstep + kstep, voffB);
        PG8_WAIT_V(6); PG8_BAR;
    } else {
        PG8_STAGE(PG8_SB(0, 0), cB, voffB); PG8_STAGE(PG8_SA(0, 0), cA, voffA); PG8_STAGE(PG8_SB(0, 1), cB + hstep, voffB); PG8_STAGE(PG8_SA(0, 1), cA + hstep, voffA);
        if (wr == 1) PG8_BAR;
        PG8_WAIT_V(4); PG8_BAR;
        PG8_STAGE(PG8_SB(1, 0), cB + kstep, voffB); PG8_STAGE(PG8_SA(1, 0), cA + kstep, voffA); PG8_STAGE(PG8_SB(1, 1), cB + hstep + kstep, voffB);
        PG8_WAIT_V(6); PG8_BAR;
    }
    for (;;) {
        const bool has_next = S.next(ui + 1, nxt);
        const char* nA = has_next ? PG8_ABASE(nxt) : cA; const char* nB = has_next ? (const char*)g.Bt + (size_t)nxt.pn * tstep : cB;
        for (int t = 0; t < nt; t += 2) {
            const bool last = (t == nt - 2);
            const char* a1 = cA + (size_t)(t + 1) * kstep;
            const char* a2 = last ? nA : cA + (size_t)(t + 2) * kstep; const char* b2 = last ? nB : cB + (size_t)(t + 2) * kstep;
            const char* a3 = a2 + kstep; const char* b3 = b2 + kstep;
            if (last && has_next) S.a_ready(nxt);
            if constexpr (SP2) {
            PG8_LDB(B0, 0, 0); PG8_LDB(B1, 0, 1); PG8_SCHED; PG8_LDA(At, 0, 0); PG8_STAGE(PG8_SA(1, 1), a1 + hstep, voffA);
            PG8_WAIT_V(8); PG8_WAIT_L(0); PG8_BAR; PG8_MMA(0, 0, At, B0); PG8_MMA(0, 1, At, B1); PG8_BAR; PG8_SCHED;
            PG8_LDA(At, 0, 1); PG8_STAGE(PG8_SB(0, 0), b2, voffB); PG8_STAGE(PG8_SB(0, 1), b2 + hstep, voffB); PG8_STAGE(PG8_SA(0, 0), a2, voffA);
            PG8_WAIT_V(8); PG8_WAIT_L(0); PG8_BAR; PG8_MMA(1, 0, At, B0); PG8_MMA(1, 1, At, B1); PG8_BAR; PG8_SCHED;
            PG8_LDB(B0, 1, 0); PG8_LDB(B1, 1, 1); PG8_SCHED; PG8_LDA(At, 1, 0); PG8_STAGE(PG8_SA(0, 1), a2 + hstep, voffA);
            PG8_WAIT_V(8); PG8_WAIT_L(0); PG8_BAR; PG8_MMA(0, 0, At, B0); PG8_MMA(0, 1, At, B1); PG8_BAR; PG8_SCHED;
            PG8_LDA(At, 1, 1); PG8_STAGE(PG8_SB(1, 0), b3, voffB); PG8_STAGE(PG8_SB(1, 1), b3 + hstep, voffB); PG8_STAGE(PG8_SA(1, 0), a3, voffA);
            PG8_WAIT_V(8); PG8_WAIT_L(0); PG8_BAR; PG8_MMA(1, 0, At, B0); PG8_MMA(1, 1, At, B1); PG8_BAR; PG8_SCHED;
            } else {
            PG8_LDB(B0, 0, 0); PG8_SCHED; PG8_LDA(At, 0, 0); PG8_STAGE(PG8_SA(1, 1), a1 + hstep, voffA);
            PG8_WAIT_L(8); PG8_BAR; PG8_WAIT_L(0); PG8_MMA(0, 0, At, B0); PG8_BAR; PG8_SCHED;
            PG8_LDB(B1, 0, 1); PG8_STAGE(PG8_SB(0, 0), b2, voffB);
            PG8_BAR; PG8_WAIT_L(0); PG8_MMA(0, 1, At, B1); PG8_BAR;
            PG8_LDA(At, 0, 1); PG8_STAGE(PG8_SA(0, 0), a2, voffA);
            PG8_BAR; PG8_WAIT_L(0); PG8_MMA(1, 0, At, B0); PG8_BAR; PG8_SCHED;
            PG8_STAGE(PG8_SB(0, 1), b2 + hstep, voffB);
            PG8_WAIT_V(6); PG8_BAR; PG8_MMA(1, 1, At, B1); PG8_BAR;
            PG8_LDB(B0, 1, 0); PG8_SCHED; PG8_LDA(At, 1, 0); PG8_STAGE(PG8_SA(0, 1), a2 + hstep, voffA);
            PG8_WAIT_L(8); PG8_BAR; PG8_WAIT_L(0); PG8_MMA(0, 0, At, B0); PG8_BAR; PG8_SCHED;
            PG8_LDB(B1, 1, 1); PG8_STAGE(PG8_SB(1, 0), b3, voffB);
            PG8_BAR; PG8_WAIT_L(0); PG8_MMA(0, 1, At, B1); PG8_BAR;
            PG8_LDA(At, 1, 1); PG8_STAGE(PG8_SA(1, 0), a3, voffA);
            PG8_BAR; PG8_WAIT_L(0); PG8_MMA(1, 0, At, B0); PG8_BAR; PG8_SCHED;
            PG8_STAGE(PG8_SB(1, 1), b3 + hstep, voffB);
            PG8_WAIT_V(6); PG8_BAR; PG8_MMA(1, 1, At, B1); PG8_BAR;
            }
        }
        if constexpr (ALIGN_EPI) { if (wr == 0) PG8_BAR; }
        if constexpr (!Epi::AFTER_DRAIN) { E(acc, cur, wr, wc, fr, fq); S.done(cur); }
        if (!has_next) break;
#pragma unroll
        for (int a = 0; a < 2; ++a)
#pragma unroll
            for (int b = 0; b < 2; ++b)
#pragma unroll
                for (int m = 0; m < 4; ++m)
#pragma unroll
                    for (int n = 0; n < 2; ++n) acc[a][b][m][n] = (f32x4){0.f, 0.f, 0.f, 0.f};
        cur = nxt; cA = nA; cB = nB; ++ui;
        if constexpr (ALIGN_EPI) { if (wr == 1) PG8_BAR; }
    }
    PG8_WAIT_V(0);
    if constexpr (!ALIGN_EPI) { if (wr == 0) PG8_BAR; }
    PG8_BAR;
#undef PG8_SA
#undef PG8_SB
#undef PG8_STAGE
#undef PG8_LDA
#undef PG8_LDB
#undef PG8_MMA
#undef PG8_WAIT_V
#undef PG8_WAIT_L
#undef PG8_BAR
#undef PG8_SCHED
#undef PG8_ABASE
}
}

#define XB_TMO      128
#define XB_XCNT(j)  (256  + 64 * (j))
#define XB_XSUB(j)  (1280 + 64 * (j))
#define XB_XGEN(j)  (2304 + 64 * (j))
#define XB_TOP      3328
#define XB_TOPGEN   3392
#define XCD_BAR_WORDS 3456
#define XB_SPIN_CAP (1u << 18)
__device__ __forceinline__ unsigned xb_ld(unsigned* p)              { return __hip_atomic_load(p, __ATOMIC_RELAXED, __HIP_MEMORY_SCOPE_AGENT); }
__device__ __forceinline__ unsigned xb_add(unsigned* p, unsigned v) { return __hip_atomic_fetch_add(p, v, __ATOMIC_RELAXED, __HIP_MEMORY_SCOPE_AGENT); }
__device__ __forceinline__ unsigned xb_xcc_id() { return (unsigned)__builtin_amdgcn_s_getreg((3 << 11) | 20) & 0xFu; }
#define XB_SPIN(cond, bar) do { unsigned _sp = 0; while (cond) { __builtin_amdgcn_s_sleep(1); \
    if ((++_sp & 255u) == 0u) { if (xb_ld(&(bar)[XB_TMO])) break; if (_sp > XB_SPIN_CAP) { atomicAdd(&(bar)[XB_TMO], 1u); break; } } } } while (0)
struct XcdBarrier { unsigned* bar; unsigned x; volatile LAS unsigned* st; };
__device__ __forceinline__ XcdBarrier xcd_barrier_post(unsigned* bar, volatile LAS unsigned* st) {
    XcdBarrier b; b.bar = bar; b.x = xb_xcc_id(); b.st = st;
    if (threadIdx.x == 0) (void)xb_add(&bar[XB_XCNT(b.x)], 1u);
    return b;
}
__device__ __forceinline__ void xcd_barrier_complete(unsigned* bar, unsigned x, unsigned& nloc, unsigned& nx) {
    const unsigned G = gridDim.x * gridDim.y * gridDim.z;
    unsigned sum, cnt, mine, sp = 0u;
    for (;;) {
        sum = 0u; cnt = 0u; mine = 0u;
#pragma unroll
        for (unsigned j = 0; j < 16; ++j) { const unsigned c = xb_ld(&bar[XB_XCNT(j)]); sum += c; cnt += (c > 0u) ? 1u : 0u; mine = (j == x) ? c : mine; }
        if (sum == G) break;
        __builtin_amdgcn_s_sleep(1);
        if ((++sp & 255u) == 0u) { if (xb_ld(&bar[XB_TMO])) break; if (sp > XB_SPIN_CAP) { atomicAdd(&bar[XB_TMO], 1u); break; } }
    }
    nloc = mine > 0u ? mine : 1u; nx = cnt > 0u ? cnt : 1u;
}
__device__ __forceinline__ void xcd_barrier(const XcdBarrier& b) {
    asm volatile("s_waitcnt vmcnt(0)" ::: "memory");
    __syncthreads();
    if (threadIdx.x == 0) {
        unsigned* bar = b.bar;
        __builtin_amdgcn_s_waitcnt(0);
        unsigned nloc = b.st[0], nx = b.st[1];
        if (nloc == 0u) { xcd_barrier_complete(bar, b.x, nloc, nx); b.st[0] = nloc; b.st[1] = nx; }
        const unsigned old = xb_add(&bar[XB_XSUB(b.x)], 1u);
        const unsigned gen = old / nloc;
        if (old + 1u == (gen + 1u) * nloc) {
            __builtin_amdgcn_fence(__ATOMIC_RELEASE, "agent");
            asm volatile("s_waitcnt vmcnt(0)" ::: "memory");
            const unsigned og = xb_add(&bar[XB_TOP], 1u);
            const unsigned tg = og / nx;
            if (og + 1u == (tg + 1u) * nx) xb_add(&bar[XB_TOPGEN], 1u);
            else XB_SPIN(xb_ld(&bar[XB_TOPGEN]) == tg, bar);
            __builtin_amdgcn_fence(__ATOMIC_ACQUIRE, "agent");
            xb_add(&bar[XB_XGEN(b.x)], 1u);
            asm volatile("s_waitcnt vmcnt(0)" ::: "memory");
        } else {
            XB_SPIN(xb_ld(&bar[XB_XGEN(b.x)]) == gen, bar);
            __builtin_amdgcn_fence(__ATOMIC_ACQUIRE, "agent");
            asm volatile("s_waitcnt vmcnt(0)" ::: "memory");
        }
    }
    __syncthreads();
}

constexpr int NWAVES = 8, NTHREADS = 512;
constexpr int LDS_BYTES = 147456;
constexpr int RING_OFF = 0, RING_BYTES = 131072, LDSCTL_OFF = RING_BYTES, MISC_OFF = LDSCTL_OFF + 320;
constexpr int CW_TMO = 0, CW_BAR = 4096;
struct Args {
    const float* in[26]; float* out; unsigned char* ws; int ph_lo, ph_hi, perm_qk, li;
};
enum Phase { P_PRO = 0, P_NORM_A1, P_GEMM_IN, P_LRU1, P_LRU2, P_GEMM_OUT, P_NORM_A2, P_UP0, P_DN0, P_NORM_B, P_QKV, P_ATTN, P_GEMM_O, P_NORM_B2, P_UP1, P_DN1, P_COUNT };

struct Frame {
    LAS unsigned char* lds; int tid, lane, wave, G;
};

__device__ __forceinline__ int qk_perm_row(int n) { const int L = n & 255; return (n & ~255) + 128 * ((L >> 5) & 1) + 32 * (L >> 6) + (L & 31); }
__device__ __forceinline__ void p0_transpose_item(const float* Wsrc, int K, int N, bf16* WT, int row_off, int perm_below, LAS float* scr, int item, int lane) {
    const int nblk = N / 32, kb = item / nblk, nb = item % nblk, k0 = 64 * kb, n0 = 32 * nb;
#pragma unroll 8
    for (int i = 0; i < 32; ++i) { const int kk = 2 * i + (lane >> 5); scr[kk * 33 + (lane & 31)] = Wsrc[(size_t)(k0 + kk) * N + n0 + (lane & 31)]; }
    asm volatile("s_waitcnt lgkmcnt(0)" ::: "memory");
    const int c = lane & 7;
#pragma unroll
    for (int j = 0; j < 4; ++j) { const int n = (lane >> 3) + 8 * j; const LAS float* s = scr + (8 * c) * 33 + n;
        v4u o; o.x = pk2(s[0 * 33], s[1 * 33]); o.y = pk2(s[2 * 33], s[3 * 33]); o.z = pk2(s[4 * 33], s[5 * 33]); o.w = pk2(s[6 * 33], s[7 * 33]);
        int drow = row_off + n0 + n; if (drow < perm_below) drow = qk_perm_row(drow);
        *(GAS v4u*)(WT + (size_t)drow * K + k0 + 8 * c) = o; }
    asm volatile("s_waitcnt lgkmcnt(0)" ::: "memory");
}

__device__ __forceinline__ void p0_prologue(Frame& F, const Args& a) {
    unsigned char* ws = a.ws;
    {
        LAS float* cact = (LAS float*)(F.lds);
        LAS float* red = (LAS float*)(F.lds + 16384);
        const float* c = a.in[1];
        for (int i = F.tid; i < BATCH * D; i += NTHREADS) { const float v = c[i]; cact[i] = v / (1.f + __expf(-v)); }
        __syncthreads();
        for (int item = blockIdx.x; item < 224; item += F.G) {
            const int gc = item * 64; const float* Wp; const float* bp; float* op; int N, j0;
            if (gc < 6144) { Wp = a.in[2]; bp = a.in[3]; op = (float*)(ws + WS_MOD0); N = 6144; j0 = gc; }
            else if (gc < 12288) { Wp = a.in[2] + (size_t)D * 6144; bp = a.in[3] + 6144; op = (float*)(ws + WS_MOD1); N = 6144; j0 = gc - 6144; }
            else { Wp = a.in[18]; bp = a.in[19]; op = (float*)(ws + WS_KVMOD); N = 2048; j0 = gc - 12288; }
            float a0 = 0.f, a1 = 0.f, a2 = 0.f, a3 = 0.f;
            const int kbase = F.wave * 128;
            const float* wp = Wp + (size_t)kbase * N + j0 + F.lane;
#pragma unroll 8
            for (int k = 0; k < 128; ++k) { const float w = wp[(size_t)k * N]; const int kk = kbase + k;
                a0 += cact[kk] * w; a1 += cact[1024 + kk] * w; a2 += cact[2048 + kk] * w; a3 += cact[3072 + kk] * w; }
            red[(F.wave * 4 + 0) * 64 + F.lane] = a0; red[(F.wave * 4 + 1) * 64 + F.lane] = a1; red[(F.wave * 4 + 2) * 64 + F.lane] = a2; red[(F.wave * 4 + 3) * 64 + F.lane] = a3;
            __syncthreads();
            if (F.tid < 256) { const int b = F.tid >> 6, l = F.tid & 63; float s = 0.f;
#pragma unroll
                for (int w = 0; w < 8; ++w) s += red[(w * 4 + b) * 64 + l];
                op[(size_t)b * N + j0 + l] = s + bp[j0 + l]; }
            __syncthreads();
        }
    }
    {
        LAS float* scr = (LAS float*)(F.lds + 32768 + F.wave * 12288);
        const int gw = blockIdx.x * NWAVES + F.wave, NGW = F.G * NWAVES;
        constexpr int I_IN = (D / 64) * (2 * W / 32), I_OUT = (W / 64) * (D / 32), I_1 = (D / 64) * (FF / 32), I_2 = (FF / 64) * (D / 32), I_Q = (D / 64) * (D / 32), I_KV = (D / 64) * (2 * D / 32), I_O = I_Q;
        constexpr int NITEMS = I_IN + I_OUT + 2 * I_1 + 2 * I_2 + I_Q + I_KV + I_O;
        const int permq = a.perm_qk ? D : 0, permkv = a.perm_qk ? 2 * D : 0;
        for (int it = gw; it < NITEMS; it += NGW) {
            int r = it;
            if (r < I_IN) { p0_transpose_item(a.in[8], D, 2 * W, (bf16*)(ws + WS_WIN), 0, 0, scr, r, F.lane); continue; } r -= I_IN;
            if (r < I_OUT) { p0_transpose_item(a.in[16], W, D, (bf16*)(ws + WS_WOUT), 0, 0, scr, r, F.lane); continue; } r -= I_OUT;
            if (r < I_1) { p0_transpose_item(a.in[6], D, FF, (bf16*)(ws + WS_W1), 0, 0, scr, r, F.lane); continue; } r -= I_1;
            if (r < I_1) { p0_transpose_item(a.in[6] + (size_t)D * FF, D, FF, (bf16*)(ws + WS_W1) + (size_t)FF * D, 0, 0, scr, r, F.lane); continue; } r -= I_1;
            if (r < I_2) { p0_transpose_item(a.in[7], FF, D, (bf16*)(ws + WS_W2), 0, 0, scr, r, F.lane); continue; } r -= I_2;
            if (r < I_2) { p0_transpose_item(a.in[7] + (size_t)D * FF, FF, D, (bf16*)(ws + WS_W2) + (size_t)FF * D, 0, 0, scr, r, F.lane); continue; } r -= I_2;
            if (r < I_Q) { p0_transpose_item(a.in[22], D, D, (bf16*)(ws + WS_WQKV), 0, permq, scr, r, F.lane); continue; } r -= I_Q;
            if (r < I_KV) { p0_transpose_item(a.in[20], D, 2 * D, (bf16*)(ws + WS_WQKV), D, permkv, scr, r, F.lane); continue; } r -= I_KV;
            p0_transpose_item(a.in[25], D, D, (bf16*)(ws + WS_WO), 0, 0, scr, r, F.lane);
        }
    }
}

__device__ __forceinline__ void norm_rows(Frame& F, const float* src, const float* g, const float* shift, const float* scale, int mstride, bf16* dst,
                                          const float* g2, const float* shift2, const float* scale2, int mstride2, bf16* dst2) {
    const int gw = blockIdx.x * NWAVES + F.wave, NGW = F.G * NWAVES;
    for (int m = gw; m < M; m += NGW) {
        const int b = m / SEQ;
        const GAS f32x4* xr = (const GAS f32x4*)(src + (size_t)m * D) + F.lane;
        f32x4 v[4]; float s = 0.f;
#pragma unroll
        for (int j = 0; j < 4; ++j) { v[j] = xr[64 * j]; s += (v[j].x * v[j].x + v[j].y * v[j].y) + (v[j].z * v[j].z + v[j].w * v[j].w); }
        const float rstd = 1.f / sqrtf(wave_sum(s) * (1.f / D) + EPS);
        {
            const GAS f32x4* gp = (const GAS f32x4*)g + F.lane; const GAS f32x4* sh = (const GAS f32x4*)(shift + (size_t)b * mstride) + F.lane; const GAS f32x4* sc = (const GAS f32x4*)(scale + (size_t)b * mstride) + F.lane;
            GAS unsigned long long* o8 = (GAS unsigned long long*)(dst + (size_t)m * D) + F.lane;
#pragma unroll
            for (int j = 0; j < 4; ++j) { const f32x4 gg = gp[64 * j], hh = sh[64 * j], cc = sc[64 * j];
                const f32x4 y = (v[j] * rstd) * gg * (cc + 1.f) + hh;
                o8[64 * j] = (unsigned long long)pk2(y.x, y.y) | ((unsigned long long)pk2(y.z, y.w) << 32); }
        }
        if (dst2) {
            const GAS f32x4* gp = (const GAS f32x4*)g2 + F.lane; const GAS f32x4* sh = (const GAS f32x4*)(shift2 + (size_t)b * mstride2) + F.lane; const GAS f32x4* sc = (const GAS f32x4*)(scale2 + (size_t)b * mstride2) + F.lane;
            GAS unsigned long long* o8 = (GAS unsigned long long*)(dst2 + (size_t)m * D) + F.lane;
#pragma unroll
            for (int j = 0; j < 4; ++j) { const f32x4 gg = gp[64 * j], hh = sh[64 * j], cc = sc[64 * j];
                const f32x4 y = (v[j] * rstd) * gg * (cc + 1.f) + hh;
                o8[64 * j] = (unsigned long long)pk2(y.x, y.y) | ((unsigned long long)pk2(y.z, y.w) << 32); }
        }
    }
}


typedef short bf16x8 __attribute__((ext_vector_type(8)));
constexpr int L_WA = 0, L_WX = 19968, L_XS = 39936, L_XC = 52800, L_AL = 77376, L_AV = 90688, L_PAR = 115264, L_SUMP = 118336, L_SUMH = 119872, L_CIN = 121408, L_END = 121792;
constexpr int LT = 64, NCHK = SEQ / LT;
template <bool FINAL>
__device__ __forceinline__ void lru_phase(Frame& F, const Args& a) {
    unsigned char* ws = a.ws;
    const bf16* Z = (const bf16*)(ws + WS_Z); bf16* YG = (bf16*)(ws + WS_YG);
    float* SA = (float*)(ws + WS_LRUA); float* SH = (float*)(ws + WS_LRUH);
    LAS unsigned char* L = F.lds;
    LAS bf16* WA = (LAS bf16*)(L + L_WA); LAS bf16* WX = (LAS bf16*)(L + L_WX); LAS bf16* XS = (LAS bf16*)(L + L_XS); LAS float* XC = (LAS float*)(L + L_XC);
    LAS bf16* AL = (LAS bf16*)(L + L_AL); LAS float* AV = (LAS float*)(L + L_AV); LAS float* PAR = (LAS float*)(L + L_PAR);
    LAS float* SUMP = (LAS float*)(L + L_SUMP); LAS float* SUMH = (LAS float*)(L + L_SUMH); LAS float* CIN = (LAS float*)(L + L_CIN);
    const int tid = F.tid, lane = F.lane, wave = F.wave, fr = lane & 15, fq = lane >> 4;
    for (int i = tid; i < L_END / 4; i += NTHREADS) ((LAS unsigned*)L)[i] = 0u;
    __syncthreads();
    int cur_n = -1;
    for (int unit = blockIdx.x; unit < NLB * BATCH * NCHK; unit += F.G) {
        const int n = unit % NLB, pair = unit / NLB, b = pair / NCHK, c = pair % NCHK;
        const size_t r0 = (size_t)b * SEQ + (size_t)c * LT;
        if (n != cur_n) {
            cur_n = n;
            const float* wa = a.in[11] + (size_t)n * LB * LB; const float* wx = a.in[13] + (size_t)n * LB * LB;
            for (int i = tid; i < LB * LB; i += NTHREADS) { const int d = i / LB, e = i % LB; WA[e * 104 + d] = (bf16)f2bf(wa[i]); WX[e * 104 + d] = (bf16)f2bf(wx[i]); }
            if (tid < LB) { const int ch = n * LB + tid;
                PAR[0 * 96 + tid] = a.in[9][0 * W + ch]; PAR[1 * 96 + tid] = a.in[9][1 * W + ch]; PAR[2 * 96 + tid] = a.in[9][2 * W + ch]; PAR[3 * 96 + tid] = a.in[9][3 * W + ch];
                PAR[4 * 96 + tid] = a.in[10][ch]; PAR[5 * 96 + tid] = a.in[12][ch]; PAR[6 * 96 + tid] = a.in[14][ch]; PAR[7 * 96 + tid] = log1pf(__expf(-a.in[15][ch])); }
        }
        for (int idx = tid; idx < (LT + 3) * 11; idx += NTHREADS) { const int r = idx / 11, j = idx % 11; const int tpos = c * LT + r - 3;
            v4u v = (v4u){0u, 0u, 0u, 0u};
            if (tpos >= 0) v = *(const GAS v4u*)(Z + ((size_t)b * SEQ + tpos) * (2 * W) + W + n * LB + 8 * j);
            *(LAS v4u*)(XS + r * 96 + 8 * j) = v; }
        if (FINAL && tid < LB) {
            const int ch = n * LB + tid; const GAS float* pa = (const GAS float*)SA + (size_t)b * NCHK * W + ch; const GAS float* ph = (const GAS float*)SH + (size_t)b * NCHK * W + ch;
            float h = 0.f;
#pragma unroll 8
            for (int cc = 0; cc < c; ++cc) h = pa[(size_t)cc * W] * h + ph[(size_t)cc * W];
            CIN[tid] = h;
        }
        __syncthreads();
#pragma unroll
        for (int k = 0; k < 11; ++k) { const int idx = tid + k * NTHREADS; const int t = idx / LB, e = idx % LB;
            const float xc = PAR[4 * 96 + e] + PAR[0 * 96 + e] * bf2f(XS[(t + 0) * 96 + e]) + PAR[1 * 96 + e] * bf2f(XS[(t + 1) * 96 + e]) + PAR[2 * 96 + e] * bf2f(XS[(t + 2) * 96 + e]) + PAR[3 * 96 + e] * bf2f(XS[(t + 3) * 96 + e]);
            XC[t * 96 + e] = xc; AL[t * 104 + e] = (bf16)f2bf(xc); }
        __syncthreads();
        {
            const int mt = wave >> 1, nt0 = (wave & 1) * 3;
            f32x4 ca[3], cx[3];
#pragma unroll
            for (int j = 0; j < 3; ++j) { ca[j] = (f32x4){0.f, 0.f, 0.f, 0.f}; cx[j] = (f32x4){0.f, 0.f, 0.f, 0.f}; }
#pragma unroll
            for (int ks = 0; ks < 3; ++ks) {
                const bf16x8 af = *(const LAS bf16x8*)(AL + (16 * mt + fr) * 104 + 32 * ks + 8 * fq);
#pragma unroll
                for (int j = 0; j < 3; ++j) {
                    const bf16x8 bA = *(const LAS bf16x8*)(WA + (16 * (nt0 + j) + fr) * 104 + 32 * ks + 8 * fq);
                    const bf16x8 bX = *(const LAS bf16x8*)(WX + (16 * (nt0 + j) + fr) * 104 + 32 * ks + 8 * fq);
                    ca[j] = __builtin_amdgcn_mfma_f32_16x16x32_bf16(af, bA, ca[j], 0, 0, 0);
                    cx[j] = __builtin_amdgcn_mfma_f32_16x16x32_bf16(af, bX, cx[j], 0, 0, 0);
                }
            }
#pragma unroll
            for (int j = 0; j < 3; ++j) { const int e = 16 * (nt0 + j) + fr;
                if (e < LB) { const float bav = PAR[5 * 96 + e], bxv = PAR[6 * 96 + e], sp = PAR[7 * 96 + e];
#pragma unroll
                    for (int rg = 0; rg < 4; ++rg) { const int t = 16 * mt + 4 * fq + rg;
                        const float pa = ca[j][rg] + bav, px = cx[j][rg] + bxv;
                        const float r = __builtin_amdgcn_rcpf(1.f + __builtin_amdgcn_exp2f(-LOG2E * pa)), ig = __builtin_amdgcn_rcpf(1.f + __builtin_amdgcn_exp2f(-LOG2E * px));
                        const float la = -8.f * r * sp; const float av = __builtin_amdgcn_exp2f(LOG2E * la);
                        const float x2 = 2.f * la;
                        float em = 1.f / 5040.f; em = em * x2 + 1.f / 720.f; em = em * x2 + 1.f / 120.f; em = em * x2 + 1.f / 24.f; em = em * x2 + 1.f / 6.f; em = em * x2 + 0.5f; em = em * x2 + 1.f; em = -x2 * em;
                        if (x2 < -0.3f) em = 1.f - av * av;
                        const float mult = sqrtf(em);
                        const float xc = XC[t * 96 + e];
                        AV[t * 96 + e] = av; XC[t * 96 + e] = mult * (ig * xc); } } }
        }
        __syncthreads();
        const int sub = tid / 96, e5 = tid % 96; const bool act = (sub < 4) && (e5 < LB);
        if (act) { float P = 1.f, Hh = 0.f;
#pragma unroll
            for (int i = 0; i < 16; ++i) { const int t = 16 * sub + i; const float av = AV[t * 96 + e5], u = XC[t * 96 + e5]; Hh = av * Hh + u; P *= av; }
            SUMP[sub * 96 + e5] = P; SUMH[sub * 96 + e5] = Hh; }
        __syncthreads();
        if (!FINAL) {
            if (tid < LB) { float P = SUMP[tid], Hh = SUMH[tid];
#pragma unroll
                for (int s2 = 1; s2 < 4; ++s2) { const float ps = SUMP[s2 * 96 + tid], hs = SUMH[s2 * 96 + tid]; Hh = ps * Hh + hs; P *= ps; }
                SA[((size_t)b * NCHK + c) * W + n * LB + tid] = P; SH[((size_t)b * NCHK + c) * W + n * LB + tid] = Hh; }
        } else {
            if (act) { float h = CIN[e5];
                for (int s2 = 0; s2 < sub; ++s2) h = SUMP[s2 * 96 + e5] * h + SUMH[s2 * 96 + e5];
#pragma unroll
                for (int i = 0; i < 16; ++i) { const int t = 16 * sub + i; h = AV[t * 96 + e5] * h + XC[t * 96 + e5]; XC[t * 96 + e5] = h; } }
            __syncthreads();
            for (int idx = tid; idx < LT * 11; idx += NTHREADS) { const int t = idx / 11, j = idx % 11;
                const v4u gv = *(const GAS v4u*)(Z + (r0 + t) * (2 * W) + n * LB + 8 * j);
                const f32x4 h0 = *(const LAS f32x4*)(XC + t * 96 + 8 * j), h1 = *(const LAS f32x4*)(XC + t * 96 + 8 * j + 4);
                float g[8] = {bf2f(gv.x & 0xffffu), bf2f(gv.x >> 16), bf2f(gv.y & 0xffffu), bf2f(gv.y >> 16), bf2f(gv.z & 0xffffu), bf2f(gv.z >> 16), bf2f(gv.w & 0xffffu), bf2f(gv.w >> 16)};
                float y[8];
#pragma unroll
                for (int q = 0; q < 8; ++q) { const float x = g[q]; const float hv = q < 4 ? h0[q & 3] : h1[q & 3];
                    const float sg = __builtin_amdgcn_rcpf(1.f + __builtin_amdgcn_exp2f(-2.302208198f * (x + 0.044715f * x * x * x)));
                    y[q] = hv * x * sg; }
                v4u o; o.x = pk2(y[0], y[1]); o.y = pk2(y[2], y[3]); o.z = pk2(y[4], y[5]); o.w = pk2(y[6], y[7]);
                *(GAS v4u*)(YG + (r0 + t) * W + n * LB + 8 * j) = o; }
        }
        __syncthreads();
    }
}

namespace attn {
typedef float f32x16 __attribute__((ext_vector_type(16)));
typedef short s16x4 __attribute__((ext_vector_type(4)));
typedef unsigned u32x4 __attribute__((ext_vector_type(4)));
typedef float f32x2_t __attribute__((ext_vector_type(2))); typedef __bf16 bf16x2_t __attribute__((ext_vector_type(2)));
constexpr int A_K = 0, A_V = 16384, A_BT = 32768, A_WS = 34816, A_OST = 36864, A_END = 69632;
__device__ __forceinline__ int crow(int r, int hi) { return (r & 3) + 8 * (r >> 2) + 4 * hi; }
__device__ __forceinline__ unsigned cvtpk_s(float lo, float hi) { f32x2_t v = {lo, hi}; bf16x2_t b = __builtin_convertvector(v, bf16x2_t); return __builtin_bit_cast(unsigned, b); }
#define ASBAR() __builtin_amdgcn_sched_barrier(0)
__device__ __forceinline__ void qkt(f32x16& p0, f32x16& p1, const LAS unsigned char* Kslot, const bf16x8* qr, const f32x16& cinit, int r32, int hi) {
    const LAS unsigned char* kb = Kslot + hi * 1024 + r32 * 16;
#pragma unroll
    for (int d0 = 0; d0 < 4; ++d0) {
        const bf16x8 b0 = *(const LAS bf16x8*)(kb + d0 * 2048);
        const bf16x8 b1 = *(const LAS bf16x8*)(kb + d0 * 2048 + 512);
        if (d0 == 0) { p0 = __builtin_amdgcn_mfma_f32_32x32x16_bf16(b0, qr[0], cinit, 0, 0, 0); p1 = __builtin_amdgcn_mfma_f32_32x32x16_bf16(b1, qr[0], cinit, 0, 0, 0); }
        else { p0 = __builtin_amdgcn_mfma_f32_32x32x16_bf16(b0, qr[d0], p0, 0, 0, 0); p1 = __builtin_amdgcn_mfma_f32_32x32x16_bf16(b1, qr[d0], p1, 0, 0, 0); }
    }
}
__device__ __forceinline__ void pv(f32x16* o, int vb, bf16x8 pa0, bf16x8 pa1, bf16x8 pa2, bf16x8 pa3) {
#pragma unroll
    for (int d0 = 0; d0 < 2; ++d0) { s16x4 lo[4], hi[4];
#pragma unroll
        for (int ks = 0; ks < 4; ++ks) {
            asm volatile("ds_read_b64_tr_b16 %0,%1 offset:%c2" : "=&v"(lo[ks]) : "v"(vb), "i"(d0 * 4096 + ks * 1024) : "memory");
            asm volatile("ds_read_b64_tr_b16 %0,%1 offset:%c2" : "=&v"(hi[ks]) : "v"(vb), "i"(d0 * 4096 + ks * 1024 + 512) : "memory"); }
        asm volatile("s_waitcnt lgkmcnt(0)" ::: "memory"); ASBAR();
#define PK(k) (bf16x8){lo[k][0], lo[k][1], lo[k][2], lo[k][3], hi[k][0], hi[k][1], hi[k][2], hi[k][3]}
        o[d0] = __builtin_amdgcn_mfma_f32_32x32x16_bf16(pa0, PK(0), o[d0], 0, 0, 0);
        o[d0] = __builtin_amdgcn_mfma_f32_32x32x16_bf16(pa1, PK(1), o[d0], 0, 0, 0);
        o[d0] = __builtin_amdgcn_mfma_f32_32x32x16_bf16(pa2, PK(2), o[d0], 0, 0, 0);
        o[d0] = __builtin_amdgcn_mfma_f32_32x32x16_bf16(pa3, PK(3), o[d0], 0, 0, 0);
#undef PK
    }
}
__device__ __forceinline__ void attn_phase(Frame& F, const Args& a) {
    unsigned char* ws = a.ws;
    const bf16* Q = (const bf16*)(ws + WS_Q); const bf16* Kg = (const bf16*)(ws + WS_K); const bf16* Vg = (const bf16*)(ws + WS_V); bf16* O = (bf16*)(ws + WS_O);
    LAS unsigned char* L = F.lds;
    const int tid = F.tid, lane = F.lane, wid = F.wave, r32 = lane & 31, hi = lane >> 5;
    LAS float* BT = (LAS float*)(L + A_BT);
    LAS float* wsf = (LAS float*)(L + A_WS) + wid * 64;
    LAS bf16* stg = (LAS bf16*)(L + A_OST) + wid * 2048;
    const unsigned lds0 = (unsigned)(uintptr_t)L;
    const int vlane = ((lane >> 4) & 1) * 32 + (lane & 3) * 8 + (4 * hi + ((lane & 15) >> 2)) * 64;
    const int NU = BATCH * H * (SEQ / CHUNK / 4);
    for (int unit = blockIdx.x; unit < NU; unit += F.G) {
        const int bh = unit % (BATCH * H), g = unit / (BATCH * H), b = bh / H, h = bh % H, c0 = 4 * g;
        const size_t rowbase = (size_t)b * SEQ;
        if (tid < 64) {
            const float* rb = a.in[24] + h * 257; float mx = -1e30f;
            for (int i = lane; i < 257; i += 64) { const float v = rb[i] * LOG2E; BT[i] = v; mx = fmaxf(mx, v); }
            float gk = fabsf(a.in[21][lane]);
#pragma unroll
            for (int o2 = 1; o2 < 64; o2 <<= 1) { mx = fmaxf(mx, __shfl_xor(mx, o2)); gk = fmaxf(gk, __shfl_xor(gk, o2)); }
            if (lane == 0) { BT[260] = mx; BT[261] = gk; }
        }
        const int ci = c0 + (wid >> 1), q0 = ci * CHUNK + 32 * (wid & 1);
        const bf16* Qw = Q + (rowbase + q0) * D + h * HD;
        bf16x8 qr[4];
#pragma unroll
        for (int d0 = 0; d0 < 4; ++d0) qr[d0] = *(const GAS bf16x8*)(Qw + (size_t)r32 * D + d0 * 16 + hi * 8);
        float ssq = 0.f;
#pragma unroll
        for (int d0 = 0; d0 < 4; ++d0)
#pragma unroll
            for (int j = 0; j < 8; ++j) { const float v = bf2f((unsigned)(unsigned short)qr[d0][j]); ssq += v * v; }
        ssq += __shfl_xor(ssq, 32);
        const int jstart = (8 - c0) > 0 ? (8 - c0) : 0;
        const bf16* ksrc = Kg + (rowbase + lane) * D + h * HD + wid * 8;
        const bf16* vsrc = Vg + (rowbase + 16 * (wid & 3) + (lane >> 2)) * D + h * HD + (wid >> 2) * 32 + (lane & 3) * 8;
        u32x4 kreg = *(const GAS u32x4*)(ksrc + (size_t)(c0 - 8 + jstart) * CHUNK * D);
        u32x4 vreg = *(const GAS u32x4*)(vsrc + (size_t)(c0 - 8 + jstart) * CHUNK * D);
        f32x16 o[2]; o[0] = f32x16{}; o[1] = f32x16{};
        float lsum = 0.f; float Bq = 0.f, bfar = 0.f;
        for (int j = jstart; j < 12; ++j) {
            const int buf = j & 1, kt = c0 - 8 + j;
            *(LAS u32x4*)(L + A_K + buf * 8192 + wid * 1024 + lane * 16) = kreg;
            *(LAS u32x4*)(L + A_V + buf * 8192 + wid * 1024 + lane * 16) = vreg;
            __syncthreads();
            if (j + 1 < 12) { kreg = *(const GAS u32x4*)(ksrc + (size_t)(kt + 1) * CHUNK * D); vreg = *(const GAS u32x4*)(vsrc + (size_t)(kt + 1) * CHUNK * D); }
            if (j == jstart) { Bq = sqrtf(ssq) * 8.05f * BT[261] + BT[260]; bfar = BT[256]; }
            const int dd = ci - kt;
            if (dd >= 0 && dd <= 8) {
                f32x16 cinit; const float cv = (dd >= 3) ? (bfar - Bq) : -Bq;
#pragma unroll
                for (int r = 0; r < 16; ++r) cinit[r] = cv;
                f32x16 p0, p1;
                qkt(p0, p1, L + A_K + buf * 8192, qr, cinit, r32, hi);
                if (dd < 3) {
                    const int base = 64 * dd + 32 * (wid & 1) + r32 + 128;
#pragma unroll
                    for (int r = 0; r < 16; ++r) { const int kc = crow(r, hi); int i0 = base - kc, i1 = base - kc - 32; i0 = i0 > 256 ? 256 : i0; i1 = i1 > 256 ? 256 : i1;
                        p0[r] += BT[i0]; p1[r] += BT[i1]; }
                }
                float sacc = 0.f;
#pragma unroll
                for (int r = 0; r < 16; ++r) { p0[r] = __builtin_amdgcn_exp2f(p0[r]); p1[r] = __builtin_amdgcn_exp2f(p1[r]); sacc += p0[r] + p1[r]; }
                lsum += sacc;
                u32x4 pw0, pw1, pw2, pw3;
                pw0 = (u32x4){cvtpk_s(p0[0], p0[1]), cvtpk_s(p0[2], p0[3]), cvtpk_s(p0[4], p0[5]), cvtpk_s(p0[6], p0[7])};
                pw1 = (u32x4){cvtpk_s(p0[8], p0[9]), cvtpk_s(p0[10], p0[11]), cvtpk_s(p0[12], p0[13]), cvtpk_s(p0[14], p0[15])};
                pw2 = (u32x4){cvtpk_s(p1[0], p1[1]), cvtpk_s(p1[2], p1[3]), cvtpk_s(p1[4], p1[5]), cvtpk_s(p1[6], p1[7])};
                pw3 = (u32x4){cvtpk_s(p1[8], p1[9]), cvtpk_s(p1[10], p1[11]), cvtpk_s(p1[12], p1[13]), cvtpk_s(p1[14], p1[15])};
                ASBAR();
                pv(o, (int)(lds0 + A_V + buf * 8192) + vlane, __builtin_bit_cast(bf16x8, pw0), __builtin_bit_cast(bf16x8, pw1), __builtin_bit_cast(bf16x8, pw2), __builtin_bit_cast(bf16x8, pw3));
            }
        }
        lsum += __shfl_xor(lsum, 32);
        if (hi == 0) wsf[32 + r32] = lsum;
        asm volatile("s_waitcnt lgkmcnt(0)" ::: "memory");
        float rli[16];
#pragma unroll
        for (int r = 0; r < 16; ++r) rli[r] = __builtin_amdgcn_rcpf(wsf[32 + crow(r, hi)]);
#pragma unroll
        for (int r = 0; r < 16; ++r) { const int orow = crow(r, hi);
#pragma unroll
            for (int d0 = 0; d0 < 2; ++d0) stg[orow * 64 + d0 * 32 + r32] = (bf16)f2bf(o[d0][r] * rli[r]); }
        asm volatile("s_waitcnt lgkmcnt(0)" ::: "memory");
        bf16* Ow = O + (rowbase + q0) * D + h * HD;
#pragma unroll
        for (int i = 0; i < 4; ++i) { const int row = i * 8 + (lane >> 3), ch = lane & 7; const u32x4 v = *(const LAS u32x4*)(stg + row * 64 + ch * 8); *(GAS u32x4*)(Ow + (size_t)row * D + ch * 8) = v; }
        __syncthreads();
    }
}
#undef ASBAR
}

__global__ void __launch_bounds__(NTHREADS, 2) mk_fwd(Args args) {
    extern __shared__ __attribute__((aligned(16))) unsigned char lds[];
    Frame F; F.lds = (LAS unsigned char*)lds; F.tid = threadIdx.x; F.lane = F.tid & 63; F.wave = __builtin_amdgcn_readfirstlane(F.tid >> 6); F.G = gridDim.x;
    unsigned char* ws = args.ws;
    const int lo = args.ph_lo, hi = args.ph_hi;
    for (int u = F.tid; u < (LDS_BYTES - LDSCTL_OFF) / 4; u += NTHREADS) ((LAS unsigned*)(F.lds + LDSCTL_OFF))[u] = 0u;
    __syncthreads();
    unsigned* ctl = (unsigned*)(ws + WS_CTL);
    XcdBarrier bar; bar.bar = ctl + CW_BAR + args.li * XCD_BAR_WORDS; bar.x = 0; bar.st = nullptr;
    if (hi - lo > 1) bar = xcd_barrier_post(ctl + CW_BAR + args.li * XCD_BAR_WORDS, (volatile LAS unsigned*)(F.lds + MISC_OFF) + 8);
#define IN(k) (lo <= (k) && (k) < hi)
#define SEAM(k) do { if (IN(k) && IN((k) + 1)) xcd_barrier(bar); } while (0)
    float* mod0 = (float*)(ws + WS_MOD0); float* mod1 = (float*)(ws + WS_MOD1); float* kvmod = (float*)(ws + WS_KVMOD);
    bf16* HNA = (bf16*)(ws + WS_HNA); bf16* HNB = (bf16*)(ws + WS_HNB); bf16* YG = (bf16*)(ws + WS_YG); bf16* Z = (bf16*)(ws + WS_Z); bf16* HB = (bf16*)(ws + WS_BIG);
    bf16* Qb = (bf16*)(ws + WS_Q); bf16* Kb = (bf16*)(ws + WS_K); bf16* Vb = (bf16*)(ws + WS_V); bf16* Ob = (bf16*)(ws + WS_O);
    bf16* WIN = (bf16*)(ws + WS_WIN); bf16* WOUT = (bf16*)(ws + WS_WOUT); bf16* W1 = (bf16*)(ws + WS_W1); bf16* W2 = (bf16*)(ws + WS_W2); bf16* WQKV = (bf16*)(ws + WS_WQKV); bf16* WO = (bf16*)(ws + WS_WO);
    const int NOA2 = 1 << 30;

    if (IN(P_PRO)) { p0_prologue(F, args); } SEAM(P_PRO);
    if (IN(P_NORM_A1)) { norm_rows(F, args.in[0], args.in[4], mod0 + 0, mod0 + 1024, 6144, HNA, nullptr, nullptr, nullptr, 0, nullptr); } SEAM(P_NORM_A1);
    if (IN(P_GEMM_IN)) {
        pg8::Gemm g{HNA, HNA, NOA2, WIN, M, 2 * W, D}; pg8::StaticOrder S; S.init(M, 2 * W, F.G, (int)blockIdx.x);
        pg8::EpiBf16<0> E{Z, 2 * W};
        pg8::gemm_phase<pg8::EpiBf16<0>, pg8::StaticOrder, true, true>(F.lds + RING_OFF, g, S, E);
    } SEAM(P_GEMM_IN);
    if (IN(P_LRU1)) { lru_phase<false>(F, args); } SEAM(P_LRU1);
    if (IN(P_LRU2)) { lru_phase<true>(F, args); } SEAM(P_LRU2);
    if (IN(P_GEMM_OUT)) {
        pg8::Gemm g{YG, YG, NOA2, WOUT, M, D, W}; pg8::StaticOrder S; S.init(M, D, F.G, (int)blockIdx.x);
        pg8::EpiRes E{args.in[0], args.out, mod0 + 2048, 6144, SEQ};
        pg8::gemm_phase<pg8::EpiRes, pg8::StaticOrder, true, true>(F.lds + RING_OFF, g, S, E);
    } SEAM(P_GEMM_OUT);
    if (IN(P_NORM_A2)) { norm_rows(F, args.out, args.in[5], mod0 + 3072, mod0 + 4096, 6144, HNA, nullptr, nullptr, nullptr, 0, nullptr); } SEAM(P_NORM_A2);
    if (IN(P_UP0)) {
        pg8::Gemm g{HNA, HNA, NOA2, W1, M, FF, D}; pg8::StaticOrder S; S.init(M, FF, F.G, (int)blockIdx.x);
        pg8::EpiBf16<2> E{HB, FF};
        pg8::gemm_phase<pg8::EpiBf16<2>, pg8::StaticOrder, true, true>(F.lds + RING_OFF, g, S, E);
    } SEAM(P_UP0);
    if (IN(P_DN0)) {
        pg8::Gemm g{HB, HB, NOA2, W2, M, D, FF}; pg8::StaticOrder S; S.init(M, D, F.G, (int)blockIdx.x);
        pg8::EpiRes E{args.out, args.out, mod0 + 5120, 6144, SEQ};
        pg8::gemm_phase<pg8::EpiRes, pg8::StaticOrder, true, true>(F.lds + RING_OFF, g, S, E);
    } SEAM(P_DN0);
    if (IN(P_NORM_B)) { norm_rows(F, args.out, args.in[4] + D, mod1 + 0, mod1 + 1024, 6144, HNA, args.in[17], kvmod + 0, kvmod + 1024, 2048, HNB); } SEAM(P_NORM_B);
    if (IN(P_QKV)) {
        pg8::Gemm g{HNA, HNB, 4, WQKV, M, 3 * D, D}; pg8::StaticOrder S; S.init(M, 3 * D, F.G, (int)blockIdx.x);
        pg8::EpiQKV E{Qb, Kb, Vb, args.in[23], args.in[21], QSCALE, EPS};
        pg8::gemm_phase<pg8::EpiQKV, pg8::StaticOrder, true, true>(F.lds + RING_OFF, g, S, E);
    } SEAM(P_QKV);
    if (IN(P_ATTN)) { attn::attn_phase(F, args); } SEAM(P_ATTN);
    if (IN(P_GEMM_O)) {
        pg8::Gemm g{Ob, Ob, NOA2, WO, M, D, D}; pg8::StaticOrder S; S.init(M, D, F.G, (int)blockIdx.x);
        pg8::EpiRes E{args.out, args.out, mod1 + 2048, 6144, SEQ};
        pg8::gemm_phase<pg8::EpiRes, pg8::StaticOrder, true, true>(F.lds + RING_OFF, g, S, E);
    } SEAM(P_GEMM_O);
    if (IN(P_NORM_B2)) { norm_rows(F, args.out, args.in[5] + D, mod1 + 3072, mod1 + 4096, 6144, HNA, nullptr, nullptr, nullptr, 0, nullptr); } SEAM(P_NORM_B2);
    if (IN(P_UP1)) {
        pg8::Gemm g{HNA, HNA, NOA2, W1 + (size_t)FF * D, M, FF, D}; pg8::StaticOrder S; S.init(M, FF, F.G, (int)blockIdx.x);
        pg8::EpiBf16<2> E{HB, FF};
        pg8::gemm_phase<pg8::EpiBf16<2>, pg8::StaticOrder, true, true>(F.lds + RING_OFF, g, S, E);
    } SEAM(P_UP1);
    if (IN(P_DN1)) {
        pg8::Gemm g{HB, HB, NOA2, W2 + (size_t)FF * D, M, D, FF}; pg8::StaticOrder S; S.init(M, D, F.G, (int)blockIdx.x);
        pg8::EpiRes E{args.out, args.out, mod1 + 5120, 6144, SEQ};
        pg8::gemm_phase<pg8::EpiRes, pg8::StaticOrder, true, true>(F.lds + RING_OFF, g, S, E);
    }
#undef SEAM
#undef IN
}

struct NEpi {
    int mode;
    bf16* O; int ldc;
    const float* base; float* out; const float* gate; int gstride;
    const float* qg; const float* kg; bf16* Q; bf16* Kb; bf16* V;
};
__global__ void __launch_bounds__(256) naive_gemm(const bf16* A, const bf16* A2, int a2_from_col, const bf16* Bt, int N, int K, NEpi e) {
    __shared__ float As[32][65];
    __shared__ float Bs[32][65];
    __shared__ float red[64][17];
    const int t = threadIdx.x, tx = t & 15, ty = t >> 4;
    const int m0 = blockIdx.y * 64, n0 = blockIdx.x * 64;
    const bf16* Ause = (n0 >= a2_from_col) ? A2 : A;
    float acc[4][4];
#pragma unroll
    for (int i = 0; i < 4; ++i)
#pragma unroll
        for (int j = 0; j < 4; ++j) acc[i][j] = 0.f;
    const int lr = t >> 2, lc = t & 3;
    for (int k0 = 0; k0 < K; k0 += 32) {
        const v4u av = *(const v4u*)(Ause + (size_t)(m0 + lr) * K + k0 + lc * 8);
        const v4u bv = *(const v4u*)(Bt + (size_t)(n0 + lr) * K + k0 + lc * 8);
        __syncthreads();
        As[lc * 8 + 0][lr] = bf2f(av.x & 0xffffu); As[lc * 8 + 1][lr] = bf2f(av.x >> 16); As[lc * 8 + 2][lr] = bf2f(av.y & 0xffffu); As[lc * 8 + 3][lr] = bf2f(av.y >> 16);
        As[lc * 8 + 4][lr] = bf2f(av.z & 0xffffu); As[lc * 8 + 5][lr] = bf2f(av.z >> 16); As[lc * 8 + 6][lr] = bf2f(av.w & 0xffffu); As[lc * 8 + 7][lr] = bf2f(av.w >> 16);
        Bs[lc * 8 + 0][lr] = bf2f(bv.x & 0xffffu); Bs[lc * 8 + 1][lr] = bf2f(bv.x >> 16); Bs[lc * 8 + 2][lr] = bf2f(bv.y & 0xffffu); Bs[lc * 8 + 3][lr] = bf2f(bv.y >> 16);
        Bs[lc * 8 + 4][lr] = bf2f(bv.z & 0xffffu); Bs[lc * 8 + 5][lr] = bf2f(bv.z >> 16); Bs[lc * 8 + 6][lr] = bf2f(bv.w & 0xffffu); Bs[lc * 8 + 7][lr] = bf2f(bv.w >> 16);
        __syncthreads();
#pragma unroll
        for (int k = 0; k < 32; ++k) {
            float av4[4], bv4[4];
#pragma unroll
            for (int i = 0; i < 4; ++i) { av4[i] = As[k][ty * 4 + i]; bv4[i] = Bs[k][tx * 4 + i]; }
#pragma unroll
            for (int i = 0; i < 4; ++i)
#pragma unroll
                for (int j = 0; j < 4; ++j) acc[i][j] += av4[i] * bv4[j];
        }
    }
    if (e.mode == 0 || e.mode == 1) {
#pragma unroll
        for (int i = 0; i < 4; ++i) { const int row = m0 + ty * 4 + i;
#pragma unroll
            for (int j = 0; j < 4; ++j) { float v = acc[i][j]; if (e.mode == 1) { v = v > 0.f ? v : 0.f; v = v * v; }
                e.O[(size_t)row * e.ldc + n0 + tx * 4 + j] = (bf16)f2bf(v); } }
    } else if (e.mode == 2) {
#pragma unroll
        for (int i = 0; i < 4; ++i) { const int row = m0 + ty * 4 + i; const int b = row / SEQ;
#pragma unroll
            for (int j = 0; j < 4; ++j) { const int col = n0 + tx * 4 + j;
                e.out[(size_t)row * D + col] = e.base[(size_t)row * D + col] + e.gate[(size_t)b * e.gstride + col] * acc[i][j]; } }
    } else {
        const int tsel = n0 / D, cbase = n0 % D;
        bf16* dst = tsel == 0 ? e.Q : (tsel == 1 ? e.Kb : e.V);
        float rs[4] = {1.f, 1.f, 1.f, 1.f};
        if (tsel < 2) {
#pragma unroll
            for (int i = 0; i < 4; ++i) { float p = 0.f;
#pragma unroll
                for (int j = 0; j < 4; ++j) p += acc[i][j] * acc[i][j];
                red[ty * 4 + i][tx] = p; }
            __syncthreads();
#pragma unroll
            for (int i = 0; i < 4; ++i) { float s = 0.f;
                for (int x = 0; x < 16; ++x) s += red[ty * 4 + i][x];
                rs[i] = 1.f / sqrtf(s * (1.f / HD) + EPS); }
        }
#pragma unroll
        for (int i = 0; i < 4; ++i) { const int row = m0 + ty * 4 + i;
#pragma unroll
            for (int j = 0; j < 4; ++j) { const int d = tx * 4 + j; float v = acc[i][j];
                if (tsel == 0) v = v * rs[i] * e.qg[d] * QSCALE; else if (tsel == 1) v = v * rs[i] * e.kg[d];
                dst[(size_t)row * D + cbase + d] = (bf16)f2bf(v); } }
    }
}

__global__ void __launch_bounds__(128) naive_lru(const bf16* Z, const float* conv_w, const float* conv_b, const float* wa, const float* ba, const float* wx, const float* bx, const float* lam, bf16* YG) {
    __shared__ float swa[LB * LB];
    __shared__ float swx[LB * LB];
    __shared__ float xcs[LB];
    const int b = blockIdx.x / NLB, n = blockIdx.x % NLB, e = threadIdx.x;
    for (int i = e; i < LB * LB; i += 128) { swa[i] = wa[(size_t)n * LB * LB + i]; swx[i] = wx[(size_t)n * LB * LB + i]; }
    const int ch = n * LB + (e < LB ? e : 0);
    const float cw0 = conv_w[0 * W + ch], cw1 = conv_w[1 * W + ch], cw2 = conv_w[2 * W + ch], cw3 = conv_w[3 * W + ch], cb = conv_b[ch];
    const float bav = ba[ch], bxv = bx[ch];
    const float sp = log1pf(__expf(-lam[ch]));
    float x0 = 0.f, x1 = 0.f, x2 = 0.f, h = 0.f;
    __syncthreads();
    for (int t = 0; t < SEQ; ++t) {
        const size_t row = (size_t)b * SEQ + t;
        const float x3 = bf2f(Z[row * (2 * W) + W + ch]);
        const float gt = bf2f(Z[row * (2 * W) + ch]);
        const float xc = cb + cw0 * x0 + cw1 * x1 + cw2 * x2 + cw3 * x3;
        x0 = x1; x1 = x2; x2 = x3;
        if (e < LB) xcs[e] = xc;
        __syncthreads();
        if (e < LB) {
            float pa = bav, px = bxv;
            for (int d = 0; d < LB; ++d) { const float xd = xcs[d]; pa += xd * swa[d * LB + e]; px += xd * swx[d * LB + e]; }
            const float r = sigmoidf_(pa), ig = sigmoidf_(px);
            const float la = -8.f * r * sp;
            const float av = __expf(la);
            const float mult = sqrtf(-expm1f(2.f * la));
            h = av * h + mult * (ig * xc);
            YG[row * W + ch] = (bf16)f2bf(h * gelu_tanh(gt));
        }
        __syncthreads();
    }
}

__global__ void __launch_bounds__(64) naive_attn(const bf16* Q, const bf16* Kb, const bf16* V, const float* rel_bias, bf16* O) {
    const int ci = blockIdx.x % (SEQ / CHUNK), h = (blockIdx.x / (SEQ / CHUNK)) % H, b = blockIdx.x / (SEQ / CHUNK * H);
    const int qi = threadIdx.x, qpos = ci * CHUNK + qi;
    const size_t qrow = (size_t)b * SEQ + qpos;
    float q[HD];
#pragma unroll
    for (int d = 0; d < HD; ++d) q[d] = bf2f(Q[qrow * D + h * HD + d]);
    const int k_lo = (ci - LEFT) * CHUNK < 0 ? 0 : (ci - LEFT) * CHUNK, k_hi = (ci + 1) * CHUNK;
    const float* rb = rel_bias + h * 257;
    float mx = -1e30f;
    for (int kp = k_lo; kp < k_hi; ++kp) {
        const v4u* kr = (const v4u*)(Kb + ((size_t)b * SEQ + kp) * D + h * HD); float s = 0.f;
#pragma unroll
        for (int c = 0; c < 8; ++c) { const v4u kv = kr[c];
            s += q[8 * c + 0] * bf2f(kv.x & 0xffffu) + q[8 * c + 1] * bf2f(kv.x >> 16) + q[8 * c + 2] * bf2f(kv.y & 0xffffu) + q[8 * c + 3] * bf2f(kv.y >> 16)
               + q[8 * c + 4] * bf2f(kv.z & 0xffffu) + q[8 * c + 5] * bf2f(kv.z >> 16) + q[8 * c + 6] * bf2f(kv.w & 0xffffu) + q[8 * c + 7] * bf2f(kv.w >> 16); }
        int rel = qpos - kp; rel = rel < -128 ? -128 : (rel > 128 ? 128 : rel);
        s += rb[rel + 128] * LOG2E;
        mx = s > mx ? s : mx;
    }
    float o[HD]; float l = 0.f;
#pragma unroll
    for (int d = 0; d < HD; ++d) o[d] = 0.f;
    for (int kp = k_lo; kp < k_hi; ++kp) {
        const v4u* kr = (const v4u*)(Kb + ((size_t)b * SEQ + kp) * D + h * HD); float s = 0.f;
#pragma unroll
        for (int c = 0; c < 8; ++c) { const v4u kv = kr[c];
            s += q[8 * c + 0] * bf2f(kv.x & 0xffffu) + q[8 * c + 1] * bf2f(kv.x >> 16) + q[8 * c + 2] * bf2f(kv.y & 0xffffu) + q[8 * c + 3] * bf2f(kv.y >> 16)
               + q[8 * c + 4] * bf2f(kv.z & 0xffffu) + q[8 * c + 5] * bf2f(kv.z >> 16) + q[8 * c + 6] * bf2f(kv.w & 0xffffu) + q[8 * c + 7] * bf2f(kv.w >> 16); }
        int rel = qpos - kp; rel = rel < -128 ? -128 : (rel > 128 ? 128 : rel);
        s += rb[rel + 128] * LOG2E;
        const float p = exp2f(s - mx); l += p;
        const v4u* vr = (const v4u*)(V + ((size_t)b * SEQ + kp) * D + h * HD);
#pragma unroll
        for (int c = 0; c < 8; ++c) { const v4u vv = vr[c];
            o[8 * c + 0] += p * bf2f(vv.x & 0xffffu); o[8 * c + 1] += p * bf2f(vv.x >> 16); o[8 * c + 2] += p * bf2f(vv.y & 0xffffu); o[8 * c + 3] += p * bf2f(vv.y >> 16);
            o[8 * c + 4] += p * bf2f(vv.z & 0xffffu); o[8 * c + 5] += p * bf2f(vv.z >> 16); o[8 * c + 6] += p * bf2f(vv.w & 0xffffu); o[8 * c + 7] += p * bf2f(vv.w >> 16); }
    }
    const float il = 1.f / l;
#pragma unroll
    for (int d = 0; d < HD; ++d) O[qrow * D + h * HD + d] = (bf16)f2bf(o[d] * il);
}

#ifndef FAST_GEMM
#define FAST_GEMM 1
#endif
#ifndef FAST_LRU
#define FAST_LRU 1
#endif
#ifndef FAST_ATTN
#define FAST_ATTN 1
#endif
extern "C" void kernel_launch(void* const* d_in, const int* in_sizes, int n_in, void* d_out, int out_size, void* d_ws, size_t ws_size, hipStream_t stream) {
    static int grid = 0;
    if (grid == 0) {
        if (n_in != 26 || out_size != M * D || ws_size < WS_END) { fprintf(stderr, "kernel_launch: unexpected shapes (n_in %d out %d ws %zu)\n", n_in, out_size, ws_size); grid = -1; return; }
        int dev = 0, cus = 0;
        if (hipGetDevice(&dev) != hipSuccess || hipDeviceGetAttribute(&cus, hipDeviceAttributeMultiprocessorCount, dev) != hipSuccess) { grid = -1; return; }
        if (hipFuncSetAttribute((const void*)mk_fwd, hipFuncAttributeMaxDynamicSharedMemorySize, LDS_BYTES) != hipSuccess) { fprintf(stderr, "kernel_launch: hipFuncSetAttribute failed\n"); grid = -1; return; }
        (void)hipGetLastError();
        grid = cus;
    }
    if (grid < 0) return;
    unsigned char* ws = (unsigned char*)d_ws;
    (void)hipMemsetAsync(ws + WS_CTL, 0, CTL_ZERO_BYTES, stream);
    Args a{};
    for (int i = 0; i < 26; ++i) a.in[i] = (const float*)d_in[i];
    a.out = (float*)d_out; a.ws = ws; a.perm_qk = 0;
    float* out = (float*)d_out; const float* x = (const float*)d_in[0];
    float* mod0 = (float*)(ws + WS_MOD0); float* mod1 = (float*)(ws + WS_MOD1);
    bf16* HNA = (bf16*)(ws + WS_HNA); bf16* HNB = (bf16*)(ws + WS_HNB); bf16* YG = (bf16*)(ws + WS_YG); bf16* Z = (bf16*)(ws + WS_Z); bf16* HB = (bf16*)(ws + WS_BIG);
    bf16* Qb = (bf16*)(ws + WS_Q); bf16* Kb = (bf16*)(ws + WS_K); bf16* Vb = (bf16*)(ws + WS_V); bf16* Ob = (bf16*)(ws + WS_O);
    bf16* WIN = (bf16*)(ws + WS_WIN); bf16* WOUT = (bf16*)(ws + WS_WOUT); bf16* W1 = (bf16*)(ws + WS_W1); bf16* W2 = (bf16*)(ws + WS_W2); bf16* WQKV = (bf16*)(ws + WS_WQKV); bf16* WO = (bf16*)(ws + WS_WO);
    int nli = 0;
    auto mk2 = [&](int p0, int p1) { a.ph_lo = p0; a.ph_hi = p1; a.li = nli++; hipLaunchKernelGGL(mk_fwd, dim3(grid), dim3(NTHREADS), LDS_BYTES, stream, a); };
    auto mk = [&](int p) { mk2(p, p + 1); };
    auto gemm = [&](const bf16* A, const bf16* A2, int a2col, const bf16* Bt, int N, int K, NEpi e) { hipLaunchKernelGGL(naive_gemm, dim3(N / 64, M / 64), dim3(256), 0, stream, A, A2, a2col, Bt, N, K, e); };
    a.perm_qk = FAST_GEMM ? 1 : 0;
#if FAST_GEMM && FAST_LRU && FAST_ATTN
    mk2(P_PRO, P_COUNT);
    (void)mk; (void)gemm; (void)x; (void)out; (void)mod0; (void)mod1; (void)HNA; (void)HNB; (void)YG; (void)Z; (void)HB; (void)Qb; (void)Kb; (void)Vb; (void)Ob; (void)WIN; (void)WOUT; (void)W1; (void)W2; (void)WQKV; (void)WO;
#else
    mk2(P_PRO, P_NORM_A1 + 1);
    if (FAST_GEMM) mk(P_GEMM_IN); else { NEpi e{}; e.mode = 0; e.O = Z; e.ldc = 2 * W; gemm(HNA, HNA, 1 << 30, WIN, 2 * W, D, e); }
    if (FAST_LRU) mk2(P_LRU1, P_LRU2 + 1); else hipLaunchKernelGGL(naive_lru, dim3(BATCH * NLB), dim3(128), 0, stream, Z, (const float*)d_in[9], (const float*)d_in[10], (const float*)d_in[11], (const float*)d_in[12], (const float*)d_in[13], (const float*)d_in[14], (const float*)d_in[15], YG);
    if (FAST_GEMM) mk2(P_GEMM_OUT, P_DN0 + 1 + 1);
    else {
        { NEpi e{}; e.mode = 2; e.base = x; e.out = out; e.gate = mod0 + 2048; e.gstride = 6144; gemm(YG, YG, 1 << 30, WOUT, D, W, e); }
        mk(P_NORM_A2);
        { NEpi e{}; e.mode = 1; e.O = HB; e.ldc = FF; gemm(HNA, HNA, 1 << 30, W1, FF, D, e); }
        { NEpi e{}; e.mode = 2; e.base = out; e.out = out; e.gate = mod0 + 5120; e.gstride = 6144; gemm(HB, HB, 1 << 30, W2, D, FF, e); }
        mk(P_NORM_B);
    }
    if (FAST_GEMM) mk(P_QKV); else { NEpi e{}; e.mode = 3; e.qg = (const float*)d_in[23]; e.kg = (const float*)d_in[21]; e.Q = Qb; e.Kb = Kb; e.V = Vb; gemm(HNA, HNB, D, WQKV, 3 * D, D, e); }
    if (FAST_ATTN) mk(P_ATTN); else hipLaunchKernelGGL(naive_attn, dim3(BATCH * H * (SEQ / CHUNK)), dim3(64), 0, stream, Qb, Kb, Vb, (const float*)d_in[24], Ob);
    if (FAST_GEMM) mk2(P_GEMM_O, P_DN1 + 1);
    else {
        { NEpi e{}; e.mode = 2; e.base = out; e.out = out; e.gate = mod1 + 2048; e.gstride = 6144; gemm(Ob, Ob, 1 << 30, WO, D, D, e); }
        mk(P_NORM_B2);
        { NEpi e{}; e.mode = 1; e.O = HB; e.ldc = FF; gemm(HNA, HNA, 1 << 30, W1 + (size_t)FF * D, FF, D, e); }
        { NEpi e{}; e.mode = 2; e.base = out; e.out = out; e.gate = mod1 + 5120; e.gstride = 6144; gemm(HB, HB, 1 << 30, W2 + (size_t)FF * D, D, FF, e); }
    }
#endif
}
```

```cpp
#include <hip/hip_runtime.h>
#include <cstdio>
#include <cstdint>

#define GAS __attribute__((address_space(1)))
#define LAS __attribute__((address_space(3)))
typedef unsigned short bf16;
typedef unsigned v4u __attribute__((ext_vector_type(4)));
typedef float f32x4 __attribute__((ext_vector_type(4)));

constexpr int BATCH = 4, SEQ = 4096, D = 1024, M = BATCH * SEQ;
constexpr int W = 1408, NLB = 16, LB = 88, FF = 4096, H = 16, HD = 64, CHUNK = 64, LEFT = 8;
constexpr float EPS = 1e-6f;
constexpr float QSCALE = 0.125f * 1.4426950408889634f;
constexpr float LOG2E = 1.4426950408889634f;

constexpr size_t MiB = 1u << 20;
constexpr size_t WS_CTL = 0, CTL_ZERO_BYTES = 1 * MiB;
constexpr size_t WS_MOD0 = 1 * MiB, WS_MOD1 = WS_MOD0 + 4 * 6144 * 4, WS_KVMOD = WS_MOD1 + 4 * 6144 * 4;
constexpr size_t WS_LRUA = 2 * MiB, WS_LRUH = WS_LRUA + (size_t)BATCH * 64 * W * 4;
constexpr size_t WS_WIN = 8 * MiB;
constexpr size_t WS_WOUT = WS_WIN + (size_t)2 * W * D * 2;
constexpr size_t WS_W1 = WS_WOUT + (size_t)D * W * 2;
constexpr size_t WS_W2 = WS_W1 + (size_t)2 * FF * D * 2;
constexpr size_t WS_WQKV = WS_W2 + (size_t)2 * FF * D * 2;
constexpr size_t WS_WO = WS_WQKV + (size_t)3 * D * D * 2;
constexpr size_t WS_WEND = WS_WO + (size_t)D * D * 2;
constexpr size_t WS_HNA = 58 * MiB;
constexpr size_t WS_YG = 90 * MiB;
constexpr size_t WS_HNB = WS_YG;
constexpr size_t WS_BIG = 128 * MiB;
constexpr size_t WS_Z = WS_BIG + 8 * MiB;
constexpr size_t WS_Q = WS_BIG, WS_K = WS_BIG + 32 * MiB, WS_V = WS_BIG + 64 * MiB, WS_O = WS_BIG + 96 * MiB;
constexpr size_t WS_END = 256 * MiB;
static_assert(WS_WEND <= WS_HNA && WS_LRUH + (size_t)BATCH * 64 * W * 4 <= WS_WIN && WS_YG + (size_t)M * W * 2 <= WS_Z && WS_Z + (size_t)M * 2 * W * 2 <= WS_END, "ws map");

__device__ __forceinline__ unsigned f2bf(float f) { unsigned u = __builtin_bit_cast(unsigned, f); return (u + 0x7fffu + ((u >> 16) & 1u)) >> 16; }
__device__ __forceinline__ unsigned pk2(float lo, float hi) { return f2bf(lo) | (f2bf(hi) << 16); }
__device__ __forceinline__ float bf2f(unsigned h) { return __builtin_bit_cast(float, h << 16); }
__device__ __forceinline__ float wave_sum(float v) {
#pragma unroll
    for (int o = 1; o < 64; o <<= 1) v += __shfl_xor(v, o);
    return v;
}
__device__ __forceinline__ float sigmoidf_(float x) { return 1.f / (1.f + __expf(-x)); }
__device__ __forceinline__ float gelu_tanh(float x) { const float u = 0.7978845608028654f * (x + 0.044715f * x * x * x); return 0.5f * x * (1.f + tanhf(u)); }


namespace pg8 {
#define PG8_LAS __attribute__((address_space(3)))
typedef unsigned short bf16_t;
typedef short bf16x8 __attribute__((ext_vector_type(8)));
typedef float f32x4 __attribute__((ext_vector_type(4)));
typedef unsigned u32x4 __attribute__((ext_vector_type(4)));
constexpr int BM = 256, BK = 64, HALF = 128, HTB = HALF * BK * 2, STAGE_BYTES = 8 * HTB, NXCD = 8, WGM = 8;
__host__ __device__ __forceinline__ int lds_byte(int r, int c) { const int st = (r >> 4) * 2 + (c >> 5), rr = r & 15, cc = c & 31, ob = rr * 64 + cc * 2; return st * 1024 + (ob ^ (((ob >> 9) & 1) << 5)); }
__host__ __device__ __forceinline__ void stage_rc(int b, int& R, int& C) { const int st = b / 1024, sb = b % 1024, swz = sb ^ (((sb >> 9) & 1) << 5); R = (st >> 1) * 16 + swz / 64; C = (st & 1) * 32 + (swz % 64) / 2; }
__host__ __device__ __forceinline__ int perm32(int rho) { const int n = rho >> 4, i = rho & 15; return 8 * (i >> 2) + 4 * n + (i & 3); }
struct Unit { int pm, pn; };
struct Gemm { const bf16_t* A; const bf16_t* A2; int a2_pn; const bf16_t* Bt; int M, N, K; };
struct StaticOrder {
    int nM, nN, nwg, G, c;
    __host__ __device__ void init(int M, int N, int G_, int c_) { nM = M / BM; nN = N / BM; nwg = nM * nN; G = G_; c = c_; }
    __host__ __device__ bool next(int i, Unit& u) const {
        const long L = (long)i * G + c; if (L >= nwg) return false;
        int wgid = (int)L; { const int q = nwg / NXCD, r = nwg % NXCD, xcd = wgid % NXCD, off = wgid / NXCD; wgid = (xcd < r ? xcd * (q + 1) : r * (q + 1) + (xcd - r) * q) + off; }
        const int nig = WGM * nN, gid = wgid / nig, fm = gid * WGM, gsz = (nM - fm) < WGM ? (nM - fm) : WGM;
        u.pm = fm + ((wgid % nig) % gsz); u.pn = (wgid % nig) / gsz; return true;
    }
    __device__ __forceinline__ void a_ready(const Unit&) const {}
    __device__ __forceinline__ void done(const Unit&) const {}
};
__device__ __forceinline__ unsigned cvt_pk_bf16(float lo, float hi) { unsigned r; asm volatile("v_cvt_pk_bf16_f32 %0, %1, %2" : "=v"(r) : "v"(lo), "v"(hi)); return r; }

template <int ACT  > struct EpiBf16 {
    static constexpr bool PERM = true, AFTER_DRAIN = false;
    bf16_t* O; int ldc;
    __device__ __forceinline__ void operator()(const f32x4 (&acc)[2][2][4][2], const Unit& u, int wr, int wc, int fr, int fq) const {
        const int row0 = u.pm * BM + wr * 64 + fr; const int col0 = u.pn * BM + wc * 32 + 8 * fq;
#pragma unroll
        for (int ai = 0; ai < 2; ++ai)
#pragma unroll
            for (int m = 0; m < 4; ++m) { bf16_t* rowp = O + (size_t)(row0 + ai * HALF + m * 16) * ldc + col0;
#pragma unroll
                for (int bj = 0; bj < 2; ++bj) { f32x4 v0 = acc[ai][bj][m][0], v1 = acc[ai][bj][m][1];
                    if (ACT == 2) {
#pragma unroll
                        for (int e = 0; e < 4; ++e) { const float a = v0[e] > 0.f ? v0[e] : 0.f, b = v1[e] > 0.f ? v1[e] : 0.f; v0[e] = a * a; v1[e] = b * b; } }
                    u32x4 w; w.x = cvt_pk_bf16(v0[0], v0[1]); w.y = cvt_pk_bf16(v0[2], v0[3]); w.z = cvt_pk_bf16(v1[0], v1[1]); w.w = cvt_pk_bf16(v1[2], v1[3]);
                    *(u32x4*)(rowp + bj * HALF) = w; } }
    }
};
struct EpiQKV {
    static constexpr bool PERM = true, AFTER_DRAIN = false;
    bf16_t* Q; bf16_t* K; bf16_t* V; const float* qg; const float* kg; float qscale, eps;
    __device__ __forceinline__ void operator()(const f32x4 (&acc)[2][2][4][2], const Unit& u, int wr, int wc, int fr, int fq) const {
        const int row0 = u.pm * BM + wr * 64 + fr; const int tsel = u.pn >> 2, ct = (u.pn & 3) * BM;
        if (tsel == 2) {
            const int col0 = ct + wc * 32 + 8 * fq;
#pragma unroll
            for (int ai = 0; ai < 2; ++ai)
#pragma unroll
                for (int m = 0; m < 4; ++m) { bf16_t* rowp = V + (size_t)(row0 + ai * HALF + m * 16) * 1024 + col0;
#pragma unroll
                    for (int bj = 0; bj < 2; ++bj) { const f32x4 v0 = acc[ai][bj][m][0], v1 = acc[ai][bj][m][1];
                        u32x4 w; w.x = cvt_pk_bf16(v0[0], v0[1]); w.y = cvt_pk_bf16(v0[2], v0[3]); w.z = cvt_pk_bf16(v1[0], v1[1]); w.w = cvt_pk_bf16(v1[2], v1[3]);
                        *(u32x4*)(rowp + bj * HALF) = w; } }
        } else {
            bf16_t* dst = tsel == 0 ? Q : K; const float* g = tsel == 0 ? qg : kg; const float sc = tsel == 0 ? qscale : 1.f;
            f32x4 gv[2][2];
#pragma unroll
            for (int bj = 0; bj < 2; ++bj)
#pragma unroll
                for (int n = 0; n < 2; ++n) gv[bj][n] = *(const f32x4*)(g + 32 * bj + 8 * fq + 4 * n) * sc;
            const int col0 = ct + 64 * wc + 8 * fq;
#pragma unroll
            for (int ai = 0; ai < 2; ++ai)
#pragma unroll
                for (int m = 0; m < 4; ++m) {
                    float s = 0.f;
#pragma unroll
                    for (int bj = 0; bj < 2; ++bj)
#pragma unroll
                        for (int n = 0; n < 2; ++n) { const f32x4 x = acc[ai][bj][m][n]; s += (x[0] * x[0] + x[1] * x[1]) + (x[2] * x[2] + x[3] * x[3]); }
                    s += __shfl_xor(s, 16); s += __shfl_xor(s, 32);
                    const float rstd = 1.0f / sqrtf(s * (1.0f / 64.0f) + eps);
                    bf16_t* rowp = dst + (size_t)(row0 + ai * HALF + m * 16) * 1024 + col0;
#pragma unroll
                    for (int bj = 0; bj < 2; ++bj) { const f32x4 v0 = acc[ai][bj][m][0] * rstd * gv[bj][0], v1 = acc[ai][bj][m][1] * rstd * gv[bj][1];
                        u32x4 w; w.x = cvt_pk_bf16(v0[0], v0[1]); w.y = cvt_pk_bf16(v0[2], v0[3]); w.z = cvt_pk_bf16(v1[0], v1[1]); w.w = cvt_pk_bf16(v1[2], v1[3]);
                        *(u32x4*)(rowp + bj * 32) = w; } }
        }
    }
};
struct EpiRes {
    static constexpr bool PERM = false, AFTER_DRAIN = false;
    const float* base; float* out; const float* gate; int gstride, rows_per_batch;
    __device__ __forceinline__ void operator()(const f32x4 (&acc)[2][2][4][2], const Unit& u, int wr, int wc, int fr, int fq) const {
        const int b = (u.pm * BM) / rows_per_batch; const int col0 = u.pn * BM + wc * 32 + 4 * fq;
        f32x4 gv[2][2];
#pragma unroll
        for (int bj = 0; bj < 2; ++bj)
#pragma unroll
            for (int n = 0; n < 2; ++n) gv[bj][n] = *(const f32x4*)(gate + (size_t)b * gstride + col0 + bj * HALF + n * 16);
#pragma unroll
        for (int ai = 0; ai < 2; ++ai)
#pragma unroll
            for (int m = 0; m < 4; ++m) { const size_t off = (size_t)(u.pm * BM + ai * HALF + wr * 64 + m * 16 + fr) * 1024 + col0;
#pragma unroll
                for (int bj = 0; bj < 2; ++bj)
#pragma unroll
                    for (int n = 0; n < 2; ++n) { const f32x4 bs = *(const f32x4*)(base + off + bj * HALF + n * 16);
                        *(f32x4*)(out + off + bj * HALF + n * 16) = bs + gv[bj][n] * acc[ai][bj][m][n]; }
                if (m & 1) asm volatile("" ::: "memory"); }
    }
};

template <class Epi, class Sched, bool ALIGN_EPI = false, bool SP2 = false>
__device__ __forceinline__ void gemm_phase(PG8_LAS unsigned char* lds, const Gemm g, const Sched& S, const Epi& E) {
    const int tid = threadIdx.x, wid = __builtin_amdgcn_readfirstlane(tid >> 6), lane = tid & 63, wr = wid >> 2, wc = wid & 3, fr = lane & 15, fq = lane >> 4;
    const int K = g.K, nt = K / BK;
    unsigned voffA[2], voffB[2];
#pragma unroll
    for (int i = 0; i < 2; ++i) { int R, C; stage_rc(tid * 16 + i * 8192, R, C); const int Rb = Epi::PERM ? ((R & ~31) + perm32(R & 31)) : R;
        voffA[i] = (unsigned)(R * K + C) * 2u; voffB[i] = (unsigned)(Rb * K + C) * 2u; }
    const size_t kstep = (size_t)(BK * 2);
    const size_t hstep = (size_t)HALF * K * 2;
    const size_t tstep = 2 * hstep;
    const unsigned ldsw = (unsigned)wid * 1024u;
    const int aoff = lds_byte(wr * 64 + fr, fq * 8), boff = lds_byte(wc * 32 + fr, fq * 8);
#define PG8_SA(b, h) (((b) * 2 + (h)) * HTB)
#define PG8_SB(b, h) ((4 + (b) * 2 + (h)) * HTB)
#define PG8_STAGE(bufoff, gbase, voff) do { _Pragma("unroll") for (int _i = 0; _i < 2; ++_i) \
        __builtin_amdgcn_global_load_lds((const unsigned*)((const char*)(gbase) + (voff)[_i]), (PG8_LAS unsigned*)(lds + (bufoff) + ldsw + _i * 8192), 16, 0, 0); } while (0)
#define PG8_LDA(dst, b, h) do { _Pragma("unroll") for (int m = 0; m < 4; ++m) _Pragma("unroll") for (int k = 0; k < 2; ++k) dst[m][k] = *(const PG8_LAS bf16x8*)(lds + PG8_SA(b, h) + aoff + m * 2048 + k * 1024); } while (0)
#define PG8_LDB(dst, b, h) do { _Pragma("unroll") for (int n = 0; n < 2; ++n) _Pragma("unroll") for (int k = 0; k < 2; ++k) dst[n][k] = *(const PG8_LAS bf16x8*)(lds + PG8_SB(b, h) + boff + n * 2048 + k * 1024); } while (0)
#define PG8_MMA(ai, bj, At, Bt) do { __builtin_amdgcn_s_setprio(1); _Pragma("unroll") for (int m = 0; m < 4; ++m) _Pragma("unroll") for (int n = 0; n < 2; ++n) _Pragma("unroll") for (int k = 0; k < 2; ++k) \
        acc[ai][bj][m][n] = __builtin_amdgcn_mfma_f32_16x16x32_bf16(Bt[n][k], At[m][k], acc[ai][bj][m][n], 0, 0, 0); __builtin_amdgcn_s_setprio(0); } while (0)
#define PG8_WAIT_V(n) asm volatile("s_waitcnt vmcnt(" #n ")" ::: "memory")
#define PG8_WAIT_L(n) asm volatile("s_waitcnt lgkmcnt(" #n ")" ::: "memory")
#define PG8_BAR __builtin_amdgcn_s_barrier()
#define PG8_SCHED __builtin_amdgcn_sched_barrier(0)
#define PG8_ABASE(u) ((const char*)((u).pn >= g.a2_pn ? g.A2 : g.A) + (size_t)(u).pm * tstep)
    Unit cur, nxt; int ui = 0;
    if (!S.next(0, cur)) return;
    f32x4 acc[2][2][4][2];
#pragma unroll
    for (int a = 0; a < 2; ++a)
#pragma unroll
        for (int b = 0; b < 2; ++b)
#pragma unroll
            for (int m = 0; m < 4; ++m)
#pragma unroll
                for (int n = 0; n < 2; ++n) acc[a][b][m][n] = (f32x4){0.f, 0.f, 0.f, 0.f};
    bf16x8 At[4][2], B0[2][2], B1[2][2];
    const char* cA = PG8_ABASE(cur); const char* cB = (const char*)g.Bt + (size_t)cur.pn * tstep;
    S.a_ready(cur);
    if constexpr (SP2) {
        PG8_STAGE(PG8_SB(0, 0), cB, voffB); PG8_STAGE(PG8_SB(0, 1), cB + hstep, voffB); PG8_STAGE(PG8_SA(0, 0), cA, voffA); PG8_STAGE(PG8_SA(0, 1), cA + hstep, voffA);
        if (wr == 1) PG8_BAR;
        PG8_WAIT_V(2); PG8_BAR;
        PG8_STAGE(PG8_SB(1, 0), cB + kstep, voffB); PG8_STAGE(PG8_SA(1, 0), cA + kstep, voffA); PG8_STAGE(PG8_SB(1, 1), cB + hstep + kstep, voffB);
        PG8_WAIT_V(6); PG8_BAR;
    } else {
        PG8_STAGE(PG8_SB(0, 0), cB, voffB); PG8_STAGE(PG8_SA(0, 0), cA, voffA); PG8_STAGE(PG8_SB(0, 1), cB + hstep, voffB); PG8_STAGE(PG8_SA(0, 1), cA + hstep, voffA);
        if (wr == 1) PG8_BAR;
        PG8_WAIT_V(4); PG8_BAR;
        PG8_STAGE(PG8_SB(1, 0), cB + kstep, voffB); PG8_STAGE(PG8_SA(1, 0), cA + kstep, voffA); PG8_STAGE(PG8_SB(1, 1), cB + hstep + kstep, voffB);
        PG8_WAIT_V(6); PG8_BAR;
    }
    for (;;) {
        const bool has_next = S.next(ui + 1, nxt);
        const char* nA = has_next ? PG8_ABASE(nxt) : cA; const char* nB = has_next ? (const char*)g.Bt + (size_t)nxt.pn * tstep : cB;
        for (int t = 0; t < nt; t += 2) {
            const bool last = (t == nt - 2);
            const char* a1 = cA + (size_t)(t + 1) * kstep;
            const char* a2 = last ? nA : cA + (size_t)(t + 2) * kstep; const char* b2 = last ? nB : cB + (size_t)(t + 2) * kstep;
            const char* a3 = a2 + kstep; const char* b3 = b2 + kstep;
            if (last && has_next) S.a_ready(nxt);
            if constexpr (SP2) {
            PG8_LDB(B0, 0, 0); PG8_LDB(B1, 0, 1); PG8_SCHED; PG8_LDA(At, 0, 0); PG8_STAGE(PG8_SA(1, 1), a1 + hstep, voffA);
            PG8_WAIT_V(8); PG8_WAIT_L(0); PG8_BAR; PG8_MMA(0, 0, At, B0); PG8_MMA(0, 1, At, B1); PG8_BAR; PG8_SCHED;
            PG8_LDA(At, 0, 1); PG8_STAGE(PG8_SB(0, 0), b2, voffB); PG8_STAGE(PG8_SB(0, 1), b2 + hstep, voffB); PG8_STAGE(PG8_SA(0, 0), a2, voffA);
            PG8_WAIT_V(8); PG8_WAIT_L(0); PG8_BAR; PG8_MMA(1, 0, At, B0); PG8_MMA(1, 1, At, B1); PG8_BAR; PG8_SCHED;
            PG8_LDB(B0, 1, 0); PG8_LDB(B1, 1, 1); PG8_SCHED; PG8_LDA(At, 1, 0); PG8_STAGE(PG8_SA(0, 1), a2 + hstep, voffA);
            PG8_WAIT_V(8); PG8_WAIT_L(0); PG8_BAR; PG8_MMA(0, 0, At, B0); PG8_MMA(0, 1, At, B1); PG8_BAR; PG8_SCHED;
            PG8_LDA(At, 1, 1); PG8_STAGE(PG8_SB(1, 0), b3, voffB); PG8_STAGE(PG8_SB(1, 1), b3 + hstep, voffB); PG8_STAGE(PG8_SA(1, 0), a3, voffA);
            PG8_WAIT_V(8); PG8_WAIT_L(0); PG8_BAR; PG8_MMA(1, 0, At, B0); PG8_MMA(1, 1, At, B1); PG8_BAR; PG8_SCHED;
            } else {
            PG8_LDB(B0, 0, 0); PG8_SCHED; PG8_LDA(At, 0, 0); PG8_STAGE(PG8_SA(1, 1), a1 + hstep, voffA);
            PG8_WAIT_L(8); PG8_BAR; PG8_WAIT_L(0); PG8_MMA(0, 0, At, B0); PG8_BAR; PG8_SCHED;
            PG8_LDB(B1, 0, 1); PG8_STAGE(PG8_SB(0, 0), b2, voffB);
            PG8_BAR; PG8_WAIT_L(0); PG8_MMA(0, 1, At, B1); PG8_BAR;
            PG8_LDA(At, 0, 1); PG8_STAGE(PG8_SA(0, 0), a2, voffA);
            PG8_BAR; PG8_WAIT_L(0); PG8_MMA(1, 0, At, B0); PG8_BAR; PG8_SCHED;
            PG8_STAGE(PG8_SB(0, 1), b2 + hstep, voffB);
            PG8_WAIT_V(6); PG8_BAR; PG8_MMA(1, 1, At, B1); PG8_BAR;
            PG8_LDB(B0, 1, 0); PG8_SCHED; PG8_LDA(At, 1, 0); PG8_STAGE(PG8_SA(0, 1), a2 + hstep, voffA);
            PG8_WAIT_L(8); PG8_BAR; PG8_WAIT_L(0); PG8_MMA(0, 0, At, B0); PG8_BAR; PG8_SCHED;
            PG8_LDB(B1, 1, 1); PG8_STAGE(PG8_SB(1, 0), b3, voffB);
            PG8_BAR; PG8_WAIT_L(0); PG8_MMA(0, 1, At, B1); PG8_BAR;
            PG8_LDA(At, 1, 1); PG8_STAGE(PG8_SA(1, 0), a3, voffA);
            PG8_BAR; PG8_WAIT_L(0); PG8_MMA(1, 0, At, B0); PG8_BAR; PG8_SCHED;
            PG8_STAGE(PG8_SB(1, 1), b3 + hstep, voffB);
            PG8_WAIT_V(6); PG8_BAR; PG8_MMA(1, 1, At, B1); PG8_BAR;
            }
        }
        if constexpr (ALIGN_EPI) { if (wr == 0) PG8_BAR; }
        if constexpr (!Epi::AFTER_DRAIN) { E(acc, cur, wr, wc, fr, fq); S.done(cur); }
        if (!has_next) break;
#pragma unroll
        for (int a = 0; a < 2; ++a)
#pragma unroll
            for (int b = 0; b < 2; ++b)
#pragma unroll
                for (int m = 0; m < 4; ++m)
#pragma unroll
                    for (int n = 0; n < 2; ++n) acc[a][b][m][n] = (f32x4){0.f, 0.f, 0.f, 0.f};
        cur = nxt; cA = nA; cB = nB; ++ui;
        if constexpr (ALIGN_EPI) { if (wr == 1) PG8_BAR; }
    }
    PG8_WAIT_V(0);
    if constexpr (!ALIGN_EPI) { if (wr == 0) PG8_BAR; }
    PG8_BAR;
#undef PG8_SA
#undef PG8_SB
#undef PG8_STAGE
#undef PG8_LDA
#undef PG8_LDB
#undef PG8_MMA
#undef PG8_WAIT_V
#undef PG8_WAIT_L
#undef PG8_BAR
#undef PG8_SCHED
#undef PG8_ABASE
}
}

#define XB_TMO      128
#define XB_XCNT(j)  (256  + 64 * (j))
#define XB_XSUB(j)  (1280 + 64 * (j))
#define XB_XGEN(j)  (2304 + 64 * (j))
#define XB_TOP      3328
#define XB_TOPGEN   3392
#define XCD_BAR_WORDS 3456
#define XB_SPIN_CAP (1u << 18)
__device__ __forceinline__ unsigned xb_ld(unsigned* p)              { return __hip_atomic_load(p, __ATOMIC_RELAXED, __HIP_MEMORY_SCOPE_AGENT); }
__device__ __forceinline__ unsigned xb_add(unsigned* p, unsigned v) { return __hip_atomic_fetch_add(p, v, __ATOMIC_RELAXED, __HIP_MEMORY_SCOPE_AGENT); }
__device__ __forceinline__ unsigned xb_xcc_id() { return (unsigned)__builtin_amdgcn_s_getreg((3 << 11) | 20) & 0xFu; }
#define XB_SPIN(cond, bar) do { unsigned _sp = 0; while (cond) { __builtin_amdgcn_s_sleep(1); \
    if ((++_sp & 255u) == 0u) { if (xb_ld(&(bar)[XB_TMO])) break; if (_sp > XB_SPIN_CAP) { atomicAdd(&(bar)[XB_TMO], 1u); break; } } } } while (0)
struct XcdBarrier { unsigned* bar; unsigned x; volatile LAS unsigned* st; };
__device__ __forceinline__ XcdBarrier xcd_barrier_post(unsigned* bar, volatile LAS unsigned* st) {
    XcdBarrier b; b.bar = bar; b.x = xb_xcc_id(); b.st = st;
    if (threadIdx.x == 0) (void)xb_add(&bar[XB_XCNT(b.x)], 1u);
    return b;
}
__device__ __forceinline__ void xcd_barrier_complete(unsigned* bar, unsigned x, unsigned& nloc, unsigned& nx) {
    const unsigned G = gridDim.x * gridDim.y * gridDim.z;
    unsigned sum, cnt, mine, sp = 0u;
    for (;;) {
        sum = 0u; cnt = 0u; mine = 0u;
#pragma unroll
        for (unsigned j = 0; j < 16; ++j) { const unsigned c = xb_ld(&bar[XB_XCNT(j)]); sum += c; cnt += (c > 0u) ? 1u : 0u; mine = (j == x) ? c : mine; }
        if (sum == G) break;
        __builtin_amdgcn_s_sleep(1);
        if ((++sp & 255u) == 0u) { if (xb_ld(&bar[XB_TMO])) break; if (sp > XB_SPIN_CAP) { atomicAdd(&bar[XB_TMO], 1u); break; } }
    }
    nloc = mine > 0u ? mine : 1u; nx = cnt > 0u ? cnt : 1u;
}
__device__ __forceinline__ void xcd_barrier(const XcdBarrier& b) {
    asm volatile("s_waitcnt vmcnt(0)" ::: "memory");
    __syncthreads();
    if (threadIdx.x == 0) {
        unsigned* bar = b.bar;
        __builtin_amdgcn_s_waitcnt(0);
        unsigned nloc = b.st[0], nx = b.st[1];
        if (nloc == 0u) { xcd_barrier_complete(bar, b.x, nloc, nx); b.st[0] = nloc; b.st[1] = nx; }
        const unsigned old = xb_add(&bar[XB_XSUB(b.x)], 1u);
        const unsigned gen = old / nloc;
        if (old + 1u == (gen + 1u) * nloc) {
            __builtin_amdgcn_fence(__ATOMIC_RELEASE, "agent");
            asm volatile("s_waitcnt vmcnt(0)" ::: "memory");
            const unsigned og = xb_add(&bar[XB_TOP], 1u);
            const unsigned tg = og / nx;
            if (og + 1u == (tg + 1u) * nx) xb_add(&bar[XB_TOPGEN], 1u);
            else XB_SPIN(xb_ld(&bar[XB_TOPGEN]) == tg, bar);
            __builtin_amdgcn_fence(__ATOMIC_ACQUIRE, "agent");
            xb_add(&bar[XB_XGEN(b.x)], 1u);
            asm volatile("s_waitcnt vmcnt(0)" ::: "memory");
        } else {
            XB_SPIN(xb_ld(&bar[XB_XGEN(b.x)]) == gen, bar);
            __builtin_amdgcn_fence(__ATOMIC_ACQUIRE, "agent");
            asm volatile("s_waitcnt vmcnt(0)" ::: "memory");
        }
    }
    __syncthreads();
}

constexpr int NWAVES = 8, NTHREADS = 512;
constexpr int LDS_BYTES = 147456;
constexpr int RING_OFF = 0, RING_BYTES = 131072, LDSCTL_OFF = RING_BYTES, MISC_OFF = LDSCTL_OFF + 320;
constexpr int CW_TMO = 0, CW_BAR = 4096;
struct Args {
    const float* in[26]; float* out; unsigned char* ws; int ph_lo, ph_hi, perm_qk, li;
    int zg, pad;
};
enum Phase { P_PRO = 0, P_NORM_A1, P_GEMM_IN, P_LRU1, P_LRU2, P_GEMM_OUT, P_NORM_A2, P_UP0, P_DN0, P_NORM_B, P_QKV, P_ATTN, P_GEMM_O, P_NORM_B2, P_UP1, P_DN1, P_COUNT };

struct Frame {
    LAS unsigned char* lds; int tid, lane, wave, G;
};

__device__ __forceinline__ int qk_perm_row(int n) { const int L = n & 255; return (n & ~255) + 128 * ((L >> 5) & 1) + 32 * (L >> 6) + (L & 31); }
__device__ __forceinline__ void p0_transpose_item(const float* Wsrc, int K, int N, bf16* WT, int row_off, int perm_below, LAS float* scr, int item, int lane) {
    const int nblk = N / 32, kb = item / nblk, nb = item % nblk, k0 = 64 * kb, n0 = 32 * nb;
#pragma unroll 8
    for (int i = 0; i < 32; ++i) { const int kk = 2 * i + (lane >> 5); scr[kk * 33 + (lane & 31)] = Wsrc[(size_t)(k0 + kk) * N + n0 + (lane & 31)]; }
    asm volatile("s_waitcnt lgkmcnt(0)" ::: "memory");
    const int c = lane & 7;
#pragma unroll
    for (int j = 0; j < 4; ++j) { const int n = (lane >> 3) + 8 * j; const LAS float* s = scr + (8 * c) * 33 + n;
        v4u o; o.x = pk2(s[0 * 33], s[1 * 33]); o.y = pk2(s[2 * 33], s[3 * 33]); o.z = pk2(s[4 * 33], s[5 * 33]); o.w = pk2(s[6 * 33], s[7 * 33]);
        int drow = row_off + n0 + n; if (drow < perm_below) drow = qk_perm_row(drow);
        *(GAS v4u*)(WT + (size_t)drow * K + k0 + 8 * c) = o; }
    asm volatile("s_waitcnt lgkmcnt(0)" ::: "memory");
}

__device__ __forceinline__ void p0_prologue(Frame& F, const Args& a) {
    unsigned char* ws = a.ws;
    {
        LAS float* cact = (LAS float*)(F.lds);
        LAS float* red = (LAS float*)(F.lds + 16384);
        const float* c = a.in[1];
        for (int i = F.tid; i < BATCH * D; i += NTHREADS) { const float v = c[i]; cact[i] = v / (1.f + __expf(-v)); }
        __syncthreads();
        for (int item = blockIdx.x; item < 224; item += F.G) {
            const int gc = item * 64; const float* Wp; const float* bp; float* op; int N, j0;
            if (gc < 6144) { Wp = a.in[2]; bp = a.in[3]; op = (float*)(ws + WS_MOD0); N = 6144; j0 = gc; }
            else if (gc < 12288) { Wp = a.in[2] + (size_t)D * 6144; bp = a.in[3] + 6144; op = (float*)(ws + WS_MOD1); N = 6144; j0 = gc - 6144; }
            else { Wp = a.in[18]; bp = a.in[19]; op = (float*)(ws + WS_KVMOD); N = 2048; j0 = gc - 12288; }
            float a0 = 0.f, a1 = 0.f, a2 = 0.f, a3 = 0.f;
            const int kbase = F.wave * 128;
            const float* wp = Wp + (size_t)kbase * N + j0 + F.lane;
#pragma unroll 8
            for (int k = 0; k < 128; ++k) { const float w = wp[(size_t)k * N]; const int kk = kbase + k;
                a0 += cact[kk] * w; a1 += cact[1024 + kk] * w; a2 += cact[2048 + kk] * w; a3 += cact[3072 + kk] * w; }
            red[(F.wave * 4 + 0) * 64 + F.lane] = a0; red[(F.wave * 4 + 1) * 64 + F.lane] = a1; red[(F.wave * 4 + 2) * 64 + F.lane] = a2; red[(F.wave * 4 + 3) * 64 + F.lane] = a3;
            __syncthreads();
            if (F.tid < 256) { const int b = F.tid >> 6, l = F.tid & 63; float s = 0.f;
#pragma unroll
                for (int w = 0; w < 8; ++w) s += red[(w * 4 + b) * 64 + l];
                op[(size_t)b * N + j0 + l] = s + bp[j0 + l]; }
            __syncthreads();
        }
    }
    {
        LAS float* scr = (LAS float*)(F.lds + 32768 + F.wave * 12288);
        const int gw = blockIdx.x * NWAVES + F.wave, NGW = F.G * NWAVES;
        constexpr int I_IN = (D / 64) * (2 * W / 32), I_OUT = (W / 64) * (D / 32), I_1 = (D / 64) * (FF / 32), I_2 = (FF / 64) * (D / 32), I_Q = (D / 64) * (D / 32), I_KV = (D / 64) * (2 * D / 32), I_O = I_Q;
        constexpr int NITEMS = I_IN + I_OUT + 2 * I_1 + 2 * I_2 + I_Q + I_KV + I_O;
        const int permq = a.perm_qk ? D : 0, permkv = a.perm_qk ? 2 * D : 0;
        for (int it = gw; it < NITEMS; it += NGW) {
            int r = it;
            if (r < I_IN) { p0_transpose_item(a.in[8], D, 2 * W, (bf16*)(ws + WS_WIN), 0, 0, scr, r, F.lane); continue; } r -= I_IN;
            if (r < I_OUT) { p0_transpose_item(a.in[16], W, D, (bf16*)(ws + WS_WOUT), 0, 0, scr, r, F.lane); continue; } r -= I_OUT;
            if (r < I_1) { p0_transpose_item(a.in[6], D, FF, (bf16*)(ws + WS_W1), 0, 0, scr, r, F.lane); continue; } r -= I_1;
            if (r < I_1) { p0_transpose_item(a.in[6] + (size_t)D * FF, D, FF, (bf16*)(ws + WS_W1) + (size_t)FF * D, 0, 0, scr, r, F.lane); continue; } r -= I_1;
            if (r < I_2) { p0_transpose_item(a.in[7], FF, D, (bf16*)(ws + WS_W2), 0, 0, scr, r, F.lane); continue; } r -= I_2;
            if (r < I_2) { p0_transpose_item(a.in[7] + (size_t)D * FF, FF, D, (bf16*)(ws + WS_W2) + (size_t)FF * D, 0, 0, scr, r, F.lane); continue; } r -= I_2;
            if (r < I_Q) { p0_transpose_item(a.in[22], D, D, (bf16*)(ws + WS_WQKV), 0, permq, scr, r, F.lane); continue; } r -= I_Q;
            if (r < I_KV) { p0_transpose_item(a.in[20], D, 2 * D, (bf16*)(ws + WS_WQKV), D, permkv, scr, r, F.lane); continue; } r -= I_KV;
            p0_transpose_item(a.in[25], D, D, (bf16*)(ws + WS_WO), 0, 0, scr, r, F.lane);
        }
    }
}

__device__ __forceinline__ void norm_rows(Frame& F, const float* src, const float* g, const float* shift, const float* scale, int mstride, bf16* dst,
                                          const float* g2, const float* shift2, const float* scale2, int mstride2, bf16* dst2) {
    const int gw = blockIdx.x * NWAVES + F.wave, NGW = F.G * NWAVES;
    for (int m = gw; m < M; m += NGW) {
        const int b = m / SEQ;
        const GAS f32x4* xr = (const GAS f32x4*)(src + (size_t)m * D) + F.lane;
        f32x4 v[4]; float s = 0.f;
#pragma unroll
        for (int j = 0; j < 4; ++j) { v[j] = xr[64 * j]; s += (v[j].x * v[j].x + v[j].y * v[j].y) + (v[j].z * v[j].z + v[j].w * v[j].w); }
        const float rstd = 1.f / sqrtf(wave_sum(s) * (1.f / D) + EPS);
        {
            const GAS f32x4* gp = (const GAS f32x4*)g + F.lane; const GAS f32x4* sh = (const GAS f32x4*)(shift + (size_t)b * mstride) + F.lane; const GAS f32x4* sc = (const GAS f32x4*)(scale + (size_t)b * mstride) + F.lane;
            GAS unsigned long long* o8 = (GAS unsigned long long*)(dst + (size_t)m * D) + F.lane;
#pragma unroll
            for (int j = 0; j < 4; ++j) { const f32x4 gg = gp[64 * j], hh = sh[64 * j], cc = sc[64 * j];
                const f32x4 y = (v[j] * rstd) * gg * (cc + 1.f) + hh;
                o8[64 * j] = (unsigned long long)pk2(y.x, y.y) | ((unsigned long long)pk2(y.z, y.w) << 32); }
        }
        if (dst2) {
            const GAS f32x4* gp = (const GAS f32x4*)g2 + F.lane; const GAS f32x4* sh = (const GAS f32x4*)(shift2 + (size_t)b * mstride2) + F.lane; const GAS f32x4* sc = (const GAS f32x4*)(scale2 + (size_t)b * mstride2) + F.lane;
            GAS unsigned long long* o8 = (GAS unsigned long long*)(dst2 + (size_t)m * D) + F.lane;
#pragma unroll
            for (int j = 0; j < 4; ++j) { const f32x4 gg = gp[64 * j], hh = sh[64 * j], cc = sc[64 * j];
                const f32x4 y = (v[j] * rstd) * gg * (cc + 1.f) + hh;
                o8[64 * j] = (unsigned long long)pk2(y.x, y.y) | ((unsigned long long)pk2(y.z, y.w) << 32); }
        }
    }
}


typedef short bf16x8 __attribute__((ext_vector_type(8)));
constexpr int L_WA = 0, L_WX = 19968, L_XS = 39936, L_XC = 52800, L_AL = 77376, L_AV = 90688, L_PAR = 115264, L_SUMP = 118336, L_SUMH = 119872, L_CIN = 121408, L_END = 122176;
constexpr int LT = 64, NCHK = SEQ / LT, GCH = 16, NGRP = NCHK / GCH;
template <bool FINAL>
__device__ __forceinline__ void lru_phase(Frame& F, const Args& a) {
    unsigned char* ws = a.ws;
    const bf16* Z = (const bf16*)(ws + WS_Z); bf16* YG = (bf16*)(ws + WS_YG);
    float* GSP = (float*)(ws + WS_LRUA); float* GSH = (float*)(ws + WS_LRUH);
    LAS unsigned char* L = F.lds;
    LAS bf16* WA = (LAS bf16*)(L + L_WA); LAS bf16* WX = (LAS bf16*)(L + L_WX); LAS bf16* XS = (LAS bf16*)(L + L_XS); LAS float* XC = (LAS float*)(L + L_XC);
    LAS bf16* AL = (LAS bf16*)(L + L_AL); LAS float* AV = (LAS float*)(L + L_AV); LAS float* PAR = (LAS float*)(L + L_PAR);
    LAS float* SUMP = (LAS float*)(L + L_SUMP); LAS float* SUMH = (LAS float*)(L + L_SUMH); LAS float* CIN = (LAS float*)(L + L_CIN);
    const int tid = F.tid, lane = F.lane, wave = F.wave, fr = lane & 15, fq = lane >> 4;
    for (int i = tid; i < L_END / 4; i += NTHREADS) ((LAS unsigned*)L)[i] = 0u;
    __syncthreads();
    int cur_n = -1;
    const int cj = tid % 11, crg = tid / 11;
    const int sub = tid / 96, e5 = tid % 96; const bool act = (sub < 4) && (e5 < LB);
    for (int su = blockIdx.x; su < NLB * BATCH * NGRP; su += F.G) {
        const int n = su % NLB, b = (su / NLB) % BATCH, k = su / (NLB * BATCH);
        if (!FINAL && k == NGRP - 1) continue;
        if (n != cur_n) {
            cur_n = n;
            const float* wa = a.in[11] + (size_t)n * LB * LB; const float* wx = a.in[13] + (size_t)n * LB * LB;
            for (int i = tid; i < LB * LB; i += NTHREADS) { const int d = i / LB, e = i % LB; WA[e * 104 + d] = (bf16)f2bf(wa[i]); WX[e * 104 + d] = (bf16)f2bf(wx[i]); }
            if (tid < LB) { const int ch = n * LB + tid;
                PAR[5 * 96 + tid] = a.in[12][ch]; PAR[6 * 96 + tid] = a.in[14][ch]; PAR[7 * 96 + tid] = -8.f * LOG2E * log1pf(__expf(-a.in[15][ch])); }
        }
        float cw[4][8], cb[8];
        { const int ch0 = n * LB + 8 * (tid < 352 ? cj : 0);
#pragma unroll
          for (int q = 0; q < 8; ++q) { cw[0][q] = a.in[9][0 * W + ch0 + q]; cw[1][q] = a.in[9][1 * W + ch0 + q]; cw[2][q] = a.in[9][2 * W + ch0 + q]; cw[3][q] = a.in[9][3 * W + ch0 + q]; cb[q] = a.in[10][ch0 + q]; } }
        if (FINAL && tid < LB) {
            const int ch = n * LB + tid; float h = 0.f;
            for (int kk = 0; kk < k; ++kk) { const float p = *(const GAS float*)(GSP + ((size_t)b * NGRP + kk) * W + ch), hh = *(const GAS float*)(GSH + ((size_t)b * NGRP + kk) * W + ch); h = p * h + hh; }
            CIN[tid] = h;
        }
        float gp = 1.f, gh = 0.f;
        const int xi0 = tid, xi1 = tid + NTHREADS;
        const int xr0 = xi0 / 11, xj0 = xi0 % 11, xr1 = xi1 / 11, xj1 = xi1 % 11;
        const int gi1 = tid + NTHREADS;
        const int gt0 = tid / 11, gj0 = tid % 11, gt1 = gi1 / 11, gj1 = gi1 % 11;
        const bf16* Zb = Z + (size_t)b * SEQ * (2 * W);
        v4u px0, px1, pg0 = (v4u){0u, 0u, 0u, 0u}, pg1 = (v4u){0u, 0u, 0u, 0u};
#define LRU_LOADX(cc) do { const int tp0 = (cc) * LT + xr0 - 3, tp1 = (cc) * LT + xr1 - 3; px0 = (v4u){0u, 0u, 0u, 0u}; px1 = (v4u){0u, 0u, 0u, 0u}; \
            if (tp0 >= 0) px0 = *(const GAS v4u*)(Zb + (size_t)tp0 * (2 * W) + W + n * LB + 8 * xj0); \
            if (xi1 < (LT + 3) * 11 && tp1 >= 0) px1 = *(const GAS v4u*)(Zb + (size_t)tp1 * (2 * W) + W + n * LB + 8 * xj1); } while (0)
#define LRU_STOREX() do { *(LAS v4u*)(XS + xr0 * 96 + 8 * xj0) = px0; if (xi1 < (LT + 3) * 11) *(LAS v4u*)(XS + xr1 * 96 + 8 * xj1) = px1; } while (0)
        LRU_LOADX(k * GCH); LRU_STOREX();
        __syncthreads();
        for (int ci = 0; ci < GCH; ++ci) {
            const int c = k * GCH + ci;
            const size_t r0 = (size_t)b * SEQ + (size_t)c * LT;
            if (ci + 1 < GCH) LRU_LOADX(c + 1);
            if (FINAL) { pg0 = *(const GAS v4u*)(Z + (r0 + gt0) * (2 * W) + n * LB + 8 * gj0); if (gi1 < LT * 11) pg1 = *(const GAS v4u*)(Z + (r0 + gt1) * (2 * W) + n * LB + 8 * gj1); }
            if (tid < 352) {
                v4u xr[5];
#pragma unroll
                for (int i = 0; i < 5; ++i) xr[i] = *(const LAS v4u*)(XS + (2 * crg + i) * 96 + 8 * cj);
#pragma unroll
                for (int rr = 0; rr < 2; ++rr) { float y[8];
#pragma unroll
                    for (int q = 0; q < 8; ++q) { float acc = cb[q];
#pragma unroll
                        for (int i = 0; i < 4; ++i) { const unsigned wd = xr[rr + i][q >> 1]; const float xv = __builtin_bit_cast(float, (q & 1) ? (wd & 0xffff0000u) : (wd << 16)); acc += cw[i][q] * xv; }
                        y[q] = acc; }
                    const int t = 2 * crg + rr;
                    *(LAS f32x4*)(XC + t * 96 + 8 * cj) = (f32x4){y[0], y[1], y[2], y[3]}; *(LAS f32x4*)(XC + t * 96 + 8 * cj + 4) = (f32x4){y[4], y[5], y[6], y[7]};
                    v4u o; o.x = pk2(y[0], y[1]); o.y = pk2(y[2], y[3]); o.z = pk2(y[4], y[5]); o.w = pk2(y[6], y[7]);
                    *(LAS v4u*)(AL + t * 104 + 8 * cj) = o; }
            }
            __syncthreads();
            {
                const int mt = wave >> 1, nt0 = (wave & 1) * 3;
                f32x4 ca[3], cx[3];
#pragma unroll
                for (int j = 0; j < 3; ++j) { ca[j] = (f32x4){0.f, 0.f, 0.f, 0.f}; cx[j] = (f32x4){0.f, 0.f, 0.f, 0.f}; }
#pragma unroll
                for (int ks = 0; ks < 3; ++ks) {
                    const bf16x8 af = *(const LAS bf16x8*)(AL + (16 * mt + fr) * 104 + 32 * ks + 8 * fq);
#pragma unroll
                    for (int j = 0; j < 3; ++j) {
                        const bf16x8 bA = *(const LAS bf16x8*)(WA + (16 * (nt0 + j) + fr) * 104 + 32 * ks + 8 * fq);
                        const bf16x8 bX = *(const LAS bf16x8*)(WX + (16 * (nt0 + j) + fr) * 104 + 32 * ks + 8 * fq);
                        ca[j] = __builtin_amdgcn_mfma_f32_16x16x32_bf16(af, bA, ca[j], 0, 0, 0);
                        cx[j] = __builtin_amdgcn_mfma_f32_16x16x32_bf16(af, bX, cx[j], 0, 0, 0);
                    }
                }
#pragma unroll
                for (int j = 0; j < 3; ++j) { const int e = 16 * (nt0 + j) + fr;
                    if (e < LB) { const float bav = PAR[5 * 96 + e], bxv = PAR[6 * 96 + e], c2 = PAR[7 * 96 + e];
#pragma unroll
                        for (int rg = 0; rg < 4; ++rg) { const int t = 16 * mt + 4 * fq + rg;
                            const float pa = ca[j][rg] + bav, px = cx[j][rg] + bxv;
                            const float r = __builtin_amdgcn_rcpf(1.f + __builtin_amdgcn_exp2f(-LOG2E * pa)), ig = __builtin_amdgcn_rcpf(1.f + __builtin_amdgcn_exp2f(-LOG2E * px));
                            const float av = __builtin_amdgcn_exp2f(r * c2);
                            const float mult = sqrtf(fmaxf(1.f - av * av, 0.f));
                            const float xc = XC[t * 96 + e];
                            AV[t * 96 + e] = av; XC[t * 96 + e] = mult * (ig * xc); } } }
            }
            __syncthreads();
            if (act) { float P = 1.f, Hh = 0.f;
#pragma unroll
                for (int i = 0; i < 16; ++i) { const int t = 16 * sub + i; const float av = AV[t * 96 + e5], u = XC[t * 96 + e5]; Hh = av * Hh + u; P *= av; }
                SUMP[sub * 96 + e5] = P; SUMH[sub * 96 + e5] = Hh; }
            __syncthreads();
            if (!FINAL) {
                if (tid < LB) {
#pragma unroll
                    for (int s2 = 0; s2 < 4; ++s2) { const float ps = SUMP[s2 * 96 + tid], hs = SUMH[s2 * 96 + tid]; gh = ps * gh + hs; gp *= ps; } }
                if (ci + 1 < GCH) LRU_STOREX();
            } else {
                if (act) { float h = CIN[(ci & 1) * 96 + e5];
                    for (int s2 = 0; s2 < sub; ++s2) h = SUMP[s2 * 96 + e5] * h + SUMH[s2 * 96 + e5];
#pragma unroll
                    for (int i = 0; i < 16; ++i) { const int t = 16 * sub + i; h = AV[t * 96 + e5] * h + XC[t * 96 + e5]; XC[t * 96 + e5] = h; }
                    if (sub == 3) CIN[((ci + 1) & 1) * 96 + e5] = h; }
                __syncthreads();
#pragma unroll
                for (int tk = 0; tk < 2; ++tk) { const int t = tk ? gt1 : gt0, j = tk ? gj1 : gj0; const v4u gv = tk ? pg1 : pg0;
                    if (tk == 0 || gi1 < LT * 11) {
                        const f32x4 h0 = *(const LAS f32x4*)(XC + t * 96 + 8 * j), h1 = *(const LAS f32x4*)(XC + t * 96 + 8 * j + 4);
                        float y[8];
#pragma unroll
                        for (int q = 0; q < 8; ++q) { const unsigned wd = gv[q >> 1]; const float x = __builtin_bit_cast(float, (q & 1) ? (wd & 0xffff0000u) : (wd << 16)); const float hv = q < 4 ? h0[q & 3] : h1[q & 3];
                            const float sg = __builtin_amdgcn_rcpf(1.f + __builtin_amdgcn_exp2f(-2.302208198f * (x + 0.044715f * x * x * x)));
                            y[q] = hv * x * sg; }
                        v4u o; o.x = pk2(y[0], y[1]); o.y = pk2(y[2], y[3]); o.z = pk2(y[4], y[5]); o.w = pk2(y[6], y[7]);
                        *(GAS v4u*)(YG + (r0 + t) * W + n * LB + 8 * j) = o; } }
                if (ci + 1 < GCH) LRU_STOREX();
            }
            __syncthreads();
        }
        if (!FINAL && tid < LB) { GSP[((size_t)b * NGRP + k) * W + n * LB + tid] = gp; GSH[((size_t)b * NGRP + k) * W + n * LB + tid] = gh; }
#undef LRU_LOADX
#undef LRU_STOREX
    }
}

namespace attn {
typedef float f32x16 __attribute__((ext_vector_type(16)));
typedef short s16x4 __attribute__((ext_vector_type(4)));
typedef unsigned u32x4 __attribute__((ext_vector_type(4)));
typedef float f32x2_t __attribute__((ext_vector_type(2))); typedef __bf16 bf16x2_t __attribute__((ext_vector_type(2)));
constexpr int A_K = 0, A_V = 16384, A_BT = 32768, A_WS = 34816, A_OST = 36864, A_END = 69632;
__device__ __forceinline__ int crow(int r, int hi) { return (r & 3) + 8 * (r >> 2) + 4 * hi; }
__device__ __forceinline__ unsigned cvtpk_s(float lo, float hi) { f32x2_t v = {lo, hi}; bf16x2_t b = __builtin_convertvector(v, bf16x2_t); return __builtin_bit_cast(unsigned, b); }
#define ASBAR() __builtin_amdgcn_sched_barrier(0)
__device__ __forceinline__ void qkt(f32x16& p0, f32x16& p1, const LAS unsigned char* Kslot, const bf16x8* qr, const f32x16& cinit, int r32, int hi) {
    const LAS unsigned char* kb = Kslot + hi * 1024 + r32 * 16;
#pragma unroll
    for (int d0 = 0; d0 < 4; ++d0) {
        const bf16x8 b0 = *(const LAS bf16x8*)(kb + d0 * 2048);
        const bf16x8 b1 = *(const LAS bf16x8*)(kb + d0 * 2048 + 512);
        if (d0 == 0) { p0 = __builtin_amdgcn_mfma_f32_32x32x16_bf16(b0, qr[0], cinit, 0, 0, 0); p1 = __builtin_amdgcn_mfma_f32_32x32x16_bf16(b1, qr[0], cinit, 0, 0, 0); }
        else { p0 = __builtin_amdgcn_mfma_f32_32x32x16_bf16(b0, qr[d0], p0, 0, 0, 0); p1 = __builtin_amdgcn_mfma_f32_32x32x16_bf16(b1, qr[d0], p1, 0, 0, 0); }
    }
}
__device__ __forceinline__ void pv(f32x16* o, int vb, bf16x8 pa0, bf16x8 pa1, bf16x8 pa2, bf16x8 pa3) {
#pragma unroll
    for (int d0 = 0; d0 < 2; ++d0) { s16x4 lo[4], hi[4];
#pragma unroll
        for (int ks = 0; ks < 4; ++ks) {
            asm volatile("ds_read_b64_tr_b16 %0,%1 offset:%c2" : "=&v"(lo[ks]) : "v"(vb), "i"(d0 * 4096 + ks * 1024) : "memory");
            asm volatile("ds_read_b64_tr_b16 %0,%1 offset:%c2" : "=&v"(hi[ks]) : "v"(vb), "i"(d0 * 4096 + ks * 1024 + 512) : "memory"); }
        asm volatile("s_waitcnt lgkmcnt(0)" ::: "memory"); ASBAR();
#define PK(k) (bf16x8){lo[k][0], lo[k][1], lo[k][2], lo[k][3], hi[k][0], hi[k][1], hi[k][2], hi[k][3]}
        o[d0] = __builtin_amdgcn_mfma_f32_32x32x16_bf16(pa0, PK(0), o[d0], 0, 0, 0);
        o[d0] = __builtin_amdgcn_mfma_f32_32x32x16_bf16(pa1, PK(1), o[d0], 0, 0, 0);
        o[d0] = __builtin_amdgcn_mfma_f32_32x32x16_bf16(pa2, PK(2), o[d0], 0, 0, 0);
        o[d0] = __builtin_amdgcn_mfma_f32_32x32x16_bf16(pa3, PK(3), o[d0], 0, 0, 0);
#undef PK
    }
}
__device__ __forceinline__ void attn_phase(Frame& F, const Args& a) {
    unsigned char* ws = a.ws;
    const bf16* Q = (const bf16*)(ws + WS_Q); const bf16* Kg = (const bf16*)(ws + WS_K); const bf16* Vg = (const bf16*)(ws + WS_V); bf16* O = (bf16*)(ws + WS_O);
    LAS unsigned char* L = F.lds;
    const int tid = F.tid, lane = F.lane, wid = F.wave, r32 = lane & 31, hi = lane >> 5;
    LAS float* BT = (LAS float*)(L + A_BT);
    LAS float* wsf = (LAS float*)(L + A_WS) + wid * 64;
    LAS bf16* stg = (LAS bf16*)(L + A_OST) + wid * 2048;
    const unsigned lds0 = (unsigned)(uintptr_t)L;
    const int vlane = ((lane >> 4) & 1) * 32 + (lane & 3) * 8 + (4 * hi + ((lane & 15) >> 2)) * 64;
    const int NU = BATCH * H * (SEQ / CHUNK / 4);
    for (int unit = blockIdx.x; unit < NU; unit += F.G) {
        const int bh = unit % (BATCH * H), g = unit / (BATCH * H), b = bh / H, h = bh % H, c0 = 4 * g;
        const size_t rowbase = (size_t)b * SEQ;
        if (tid < 64) {
            const float* rb = a.in[24] + h * 257; float mx = -1e30f;
            for (int i = lane; i < 257; i += 64) { const float v = rb[i] * LOG2E; BT[i] = v; mx = fmaxf(mx, v); }
            float gk = fabsf(a.in[21][lane]);
#pragma unroll
            for (int o2 = 1; o2 < 64; o2 <<= 1) { mx = fmaxf(mx, __shfl_xor(mx, o2)); gk = fmaxf(gk, __shfl_xor(gk, o2)); }
            if (lane == 0) { BT[260] = mx; BT[261] = gk; }
        }
        const int ci = c0 + (wid >> 1), q0 = ci * CHUNK + 32 * (wid & 1);
        const bf16* Qw = Q + (rowbase + q0) * D + h * HD;
        bf16x8 qr[4];
#pragma unroll
        for (int d0 = 0; d0 < 4; ++d0) qr[d0] = *(const GAS bf16x8*)(Qw + (size_t)r32 * D + d0 * 16 + hi * 8);
        float ssq = 0.f;
#pragma unroll
        for (int d0 = 0; d0 < 4; ++d0)
#pragma unroll
            for (int j = 0; j < 8; ++j) { const float v = bf2f((unsigned)(unsigned short)qr[d0][j]); ssq += v * v; }
        ssq += __shfl_xor(ssq, 32);
        const int jstart = (8 - c0) > 0 ? (8 - c0) : 0;
        const bf16* ksrc = Kg + (rowbase + lane) * D + h * HD + wid * 8;
        const bf16* vsrc = Vg + (rowbase + 16 * (wid & 3) + (lane >> 2)) * D + h * HD + (wid >> 2) * 32 + (lane & 3) * 8;
        u32x4 kreg = *(const GAS u32x4*)(ksrc + (size_t)(c0 - 8 + jstart) * CHUNK * D);
        u32x4 vreg = *(const GAS u32x4*)(vsrc + (size_t)(c0 - 8 + jstart) * CHUNK * D);
        f32x16 o[2]; o[0] = f32x16{}; o[1] = f32x16{};
        float lsum = 0.f; float Bq = 0.f, bfar = 0.f;
        for (int j = jstart; j < 12; ++j) {
            const int buf = j & 1, kt = c0 - 8 + j;
            *(LAS u32x4*)(L + A_K + buf * 8192 + wid * 1024 + lane * 16) = kreg;
            *(LAS u32x4*)(L + A_V + buf * 8192 + wid * 1024 + lane * 16) = vreg;
            __syncthreads();
            if (j + 1 < 12) { kreg = *(const GAS u32x4*)(ksrc + (size_t)(kt + 1) * CHUNK * D); vreg = *(const GAS u32x4*)(vsrc + (size_t)(kt + 1) * CHUNK * D); }
            if (j == jstart) { Bq = sqrtf(ssq) * 8.05f * BT[261] + BT[260]; bfar = BT[256]; }
            const int dd = ci - kt;
            if (dd >= 0 && dd <= 8) {
                f32x16 cinit; const float cv = (dd >= 3) ? (bfar - Bq) : -Bq;
#pragma unroll
                for (int r = 0; r < 16; ++r) cinit[r] = cv;
                f32x16 p0, p1;
                qkt(p0, p1, L + A_K + buf * 8192, qr, cinit, r32, hi);
                if (dd < 3) {
                    const int base = 64 * dd + 32 * (wid & 1) + r32 + 128;
#pragma unroll
                    for (int r = 0; r < 16; ++r) { const int kc = crow(r, hi); int i0 = base - kc, i1 = base - kc - 32; i0 = i0 > 256 ? 256 : i0; i1 = i1 > 256 ? 256 : i1;
                        p0[r] += BT[i0]; p1[r] += BT[i1]; }
                }
                float sacc = 0.f;
#pragma unroll
                for (int r = 0; r < 16; ++r) { p0[r] = __builtin_amdgcn_exp2f(p0[r]); p1[r] = __builtin_amdgcn_exp2f(p1[r]); sacc += p0[r] + p1[r]; }
                lsum += sacc;
                u32x4 pw0, pw1, pw2, pw3;
                pw0 = (u32x4){cvtpk_s(p0[0], p0[1]), cvtpk_s(p0[2], p0[3]), cvtpk_s(p0[4], p0[5]), cvtpk_s(p0[6], p0[7])};
                pw1 = (u32x4){cvtpk_s(p0[8], p0[9]), cvtpk_s(p0[10], p0[11]), cvtpk_s(p0[12], p0[13]), cvtpk_s(p0[14], p0[15])};
                pw2 = (u32x4){cvtpk_s(p1[0], p1[1]), cvtpk_s(p1[2], p1[3]), cvtpk_s(p1[4], p1[5]), cvtpk_s(p1[6], p1[7])};
                pw3 = (u32x4){cvtpk_s(p1[8], p1[9]), cvtpk_s(p1[10], p1[11]), cvtpk_s(p1[12], p1[13]), cvtpk_s(p1[14], p1[15])};
                ASBAR();
                pv(o, (int)(lds0 + A_V + buf * 8192) + vlane, __builtin_bit_cast(bf16x8, pw0), __builtin_bit_cast(bf16x8, pw1), __builtin_bit_cast(bf16x8, pw2), __builtin_bit_cast(bf16x8, pw3));
            }
        }
        lsum += __shfl_xor(lsum, 32);
        if (hi == 0) wsf[32 + r32] = lsum;
        asm volatile("s_waitcnt lgkmcnt(0)" ::: "memory");
        float rli[16];
#pragma unroll
        for (int r = 0; r < 16; ++r) rli[r] = __builtin_amdgcn_rcpf(wsf[32 + crow(r, hi)]);
#pragma unroll
        for (int r = 0; r < 16; ++r) { const int orow = crow(r, hi);
#pragma unroll
            for (int d0 = 0; d0 < 2; ++d0) stg[orow * 64 + d0 * 32 + r32] = (bf16)f2bf(o[d0][r] * rli[r]); }
        asm volatile("s_waitcnt lgkmcnt(0)" ::: "memory");
        bf16* Ow = O + (rowbase + q0) * D + h * HD;
#pragma unroll
        for (int i = 0; i < 4; ++i) { const int row = i * 8 + (lane >> 3), ch = lane & 7; const u32x4 v = *(const LAS u32x4*)(stg + row * 64 + ch * 8); *(GAS u32x4*)(Ow + (size_t)row * D + ch * 8) = v; }
        __syncthreads();
    }
}
#undef ASBAR
}

__global__ void __launch_bounds__(NTHREADS, 2) mk_fwd(Args args) {
    extern __shared__ __attribute__((aligned(16))) unsigned char lds[];
    Frame F; F.lds = (LAS unsigned char*)lds; F.tid = threadIdx.x; F.lane = F.tid & 63; F.wave = __builtin_amdgcn_readfirstlane(F.tid >> 6); F.G = gridDim.x;
    unsigned char* ws = args.ws;
    const int lo = args.ph_lo, hi = args.ph_hi;
    for (int u = F.tid; u < (LDS_BYTES - LDSCTL_OFF) / 4; u += NTHREADS) ((LAS unsigned*)(F.lds + LDSCTL_OFF))[u] = 0u;
    __syncthreads();
    unsigned* ctl = (unsigned*)(ws + WS_CTL);
    XcdBarrier bar; bar.bar = ctl + CW_BAR + args.li * XCD_BAR_WORDS; bar.x = 0; bar.st = nullptr;
    if (hi - lo > 1) bar = xcd_barrier_post(ctl + CW_BAR + args.li * XCD_BAR_WORDS, (volatile LAS unsigned*)(F.lds + MISC_OFF) + 8);
#define IN(k) (lo <= (k) && (k) < hi)
#define SEAM(k) do { if (IN(k) && IN((k) + 1)) xcd_barrier(bar); } while (0)
    float* mod0 = (float*)(ws + WS_MOD0); float* mod1 = (float*)(ws + WS_MOD1); float* kvmod = (float*)(ws + WS_KVMOD);
    bf16* HNA = (bf16*)(ws + WS_HNA); bf16* HNB = (bf16*)(ws + WS_HNB); bf16* YG = (bf16*)(ws + WS_YG); bf16* Z = (bf16*)(ws + WS_Z); bf16* HB = (bf16*)(ws + WS_BIG);
    bf16* Qb = (bf16*)(ws + WS_Q); bf16* Kb = (bf16*)(ws + WS_K); bf16* Vb = (bf16*)(ws + WS_V); bf16* Ob = (bf16*)(ws + WS_O);
    bf16* WIN = (bf16*)(ws + WS_WIN); bf16* WOUT = (bf16*)(ws + WS_WOUT); bf16* W1 = (bf16*)(ws + WS_W1); bf16* W2 = (bf16*)(ws + WS_W2); bf16* WQKV = (bf16*)(ws + WS_WQKV); bf16* WO = (bf16*)(ws + WS_WO);
    const int NOA2 = 1 << 30;

    if (IN(P_PRO)) { p0_prologue(F, args); } SEAM(P_PRO);
    if (IN(P_NORM_A1)) { norm_rows(F, args.in[0], args.in[4], mod0 + 0, mod0 + 1024, 6144, HNA, nullptr, nullptr, nullptr, 0, nullptr); } SEAM(P_NORM_A1);
    if (IN(P_GEMM_IN)) {
        pg8::Gemm g{HNA, HNA, NOA2, WIN, M, 2 * W, D}; pg8::StaticOrder S; S.init(M, 2 * W, F.G, (int)blockIdx.x);
        pg8::EpiBf16<0> E{Z, 2 * W};
        pg8::gemm_phase<pg8::EpiBf16<0>, pg8::StaticOrder, true, true>(F.lds + RING_OFF, g, S, E);
    } SEAM(P_GEMM_IN);
    if (IN(P_LRU1)) { lru_phase<false>(F, args); } SEAM(P_LRU1);
    if (IN(P_LRU2)) { lru_phase<true>(F, args); } SEAM(P_LRU2);
    if (IN(P_GEMM_OUT)) {
        pg8::Gemm g{YG, YG, NOA2, WOUT, M, D, W}; pg8::StaticOrder S; S.init(M, D, F.G, (int)blockIdx.x);
        pg8::EpiRes E{args.zg ? (const float*)args.out : args.in[0], args.out, args.zg ? (const float*)(ws + WS_CTL + 512 * 1024) : mod0 + 2048, 6144, SEQ};
        pg8::gemm_phase<pg8::EpiRes, pg8::StaticOrder, true, true>(F.lds + RING_OFF, g, S, E);
    } SEAM(P_GEMM_OUT);
    if (IN(P_NORM_A2)) { norm_rows(F, args.out, args.in[5], mod0 + 3072, mod0 + 4096, 6144, HNA, nullptr, nullptr, nullptr, 0, nullptr); } SEAM(P_NORM_A2);
    if (IN(P_UP0)) {
        pg8::Gemm g{HNA, HNA, NOA2, W1, M, FF, D}; pg8::StaticOrder S; S.init(M, FF, F.G, (int)blockIdx.x);
        pg8::EpiBf16<2> E{HB, FF};
        pg8::gemm_phase<pg8::EpiBf16<2>, pg8::StaticOrder, true, true>(F.lds + RING_OFF, g, S, E);
    } SEAM(P_UP0);
    if (IN(P_DN0)) {
        pg8::Gemm g{HB, HB, NOA2, W2, M, D, FF}; pg8::StaticOrder S; S.init(M, D, F.G, (int)blockIdx.x);
        pg8::EpiRes E{args.out, args.out, args.zg ? (const float*)(ws + WS_CTL + 512 * 1024) : mod0 + 5120, 6144, SEQ};
        pg8::gemm_phase<pg8::EpiRes, pg8::StaticOrder, true, true>(F.lds + RING_OFF, g, S, E);
    } SEAM(P_DN0);
    if (IN(P_NORM_B)) { norm_rows(F, args.out, args.in[4] + D, mod1 + 0, mod1 + 1024, 6144, HNA, args.in[17], kvmod + 0, kvmod + 1024, 2048, HNB); } SEAM(P_NORM_B);
    if (IN(P_QKV)) {
        pg8::Gemm g{HNA, HNB, 4, WQKV, M, 3 * D, D}; pg8::StaticOrder S; S.init(M, 3 * D, F.G, (int)blockIdx.x);
        pg8::EpiQKV E{Qb, Kb, Vb, args.in[23], args.in[21], QSCALE, EPS};
        pg8::gemm_phase<pg8::EpiQKV, pg8::StaticOrder, true, true>(F.lds + RING_OFF, g, S, E);
    } SEAM(P_QKV);
    if (IN(P_ATTN)) { attn::attn_phase(F, args); } SEAM(P_ATTN);
    if (IN(P_GEMM_O)) {
        pg8::Gemm g{Ob, Ob, NOA2, WO, M, D, D}; pg8::StaticOrder S; S.init(M, D, F.G, (int)blockIdx.x);
        pg8::EpiRes E{args.out, args.out, args.zg ? (const float*)(ws + WS_CTL + 512 * 1024) : mod1 + 2048, 6144, SEQ};
        pg8::gemm_phase<pg8::EpiRes, pg8::StaticOrder, true, true>(F.lds + RING_OFF, g, S, E);
    } SEAM(P_GEMM_O);
    if (IN(P_NORM_B2)) { norm_rows(F, args.out, args.in[5] + D, mod1 + 3072, mod1 + 4096, 6144, HNA, nullptr, nullptr, nullptr, 0, nullptr); } SEAM(P_NORM_B2);
    if (IN(P_UP1)) {
        pg8::Gemm g{HNA, HNA, NOA2, W1 + (size_t)FF * D, M, FF, D}; pg8::StaticOrder S; S.init(M, FF, F.G, (int)blockIdx.x);
        pg8::EpiBf16<2> E{HB, FF};
        pg8::gemm_phase<pg8::EpiBf16<2>, pg8::StaticOrder, true, true>(F.lds + RING_OFF, g, S, E);
    } SEAM(P_UP1);
    if (IN(P_DN1)) {
        pg8::Gemm g{HB, HB, NOA2, W2 + (size_t)FF * D, M, D, FF}; pg8::StaticOrder S; S.init(M, D, F.G, (int)blockIdx.x);
        pg8::EpiRes E{args.out, args.out, args.zg ? (const float*)(ws + WS_CTL + 512 * 1024) : mod1 + 5120, 6144, SEQ};
        pg8::gemm_phase<pg8::EpiRes, pg8::StaticOrder, true, true>(F.lds + RING_OFF, g, S, E);
    }
#undef SEAM
#undef IN
}

struct NEpi {
    int mode;
    bf16* O; int ldc;
    const float* base; float* out; const float* gate; int gstride;
    const float* qg; const float* kg; bf16* Q; bf16* Kb; bf16* V;
};
__global__ void __launch_bounds__(256) naive_gemm(const bf16* A, const bf16* A2, int a2_from_col, const bf16* Bt, int N, int K, NEpi e) {
    __shared__ float As[32][65];
    __shared__ float Bs[32][65];
    __shared__ float red[64][17];
    const int t = threadIdx.x, tx = t & 15, ty = t >> 4;
    const int m0 = blockIdx.y * 64, n0 = blockIdx.x * 64;
    const bf16* Ause = (n0 >= a2_from_col) ? A2 : A;
    float acc[4][4];
#pragma unroll
    for (int i = 0; i < 4; ++i)
#pragma unroll
        for (int j = 0; j < 4; ++j) acc[i][j] = 0.f;
    const int lr = t >> 2, lc = t & 3;
    for (int k0 = 0; k0 < K; k0 += 32) {
        const v4u av = *(const v4u*)(Ause + (size_t)(m0 + lr) * K + k0 + lc * 8);
        const v4u bv = *(const v4u*)(Bt + (size_t)(n0 + lr) * K + k0 + lc * 8);
        __syncthreads();
        As[lc * 8 + 0][lr] = bf2f(av.x & 0xffffu); As[lc * 8 + 1][lr] = bf2f(av.x >> 16); As[lc * 8 + 2][lr] = bf2f(av.y & 0xffffu); As[lc * 8 + 3][lr] = bf2f(av.y >> 16);
        As[lc * 8 + 4][lr] = bf2f(av.z & 0xffffu); As[lc * 8 + 5][lr] = bf2f(av.z >> 16); As[lc * 8 + 6][lr] = bf2f(av.w & 0xffffu); As[lc * 8 + 7][lr] = bf2f(av.w >> 16);
        Bs[lc * 8 + 0][lr] = bf2f(bv.x & 0xffffu); Bs[lc * 8 + 1][lr] = bf2f(bv.x >> 16); Bs[lc * 8 + 2][lr] = bf2f(bv.y & 0xffffu); Bs[lc * 8 + 3][lr] = bf2f(bv.y >> 16);
        Bs[lc * 8 + 4][lr] = bf2f(bv.z & 0xffffu); Bs[lc * 8 + 5][lr] = bf2f(bv.z >> 16); Bs[lc * 8 + 6][lr] = bf2f(bv.w & 0xffffu); Bs[lc * 8 + 7][lr] = bf2f(bv.w >> 16);
        __syncthreads();
#pragma unroll
        for (int k = 0; k < 32; ++k) {
            float av4[4], bv4[4];
#pragma unroll
            for (int i = 0; i < 4; ++i) { av4[i] = As[k][ty * 4 + i]; bv4[i] = Bs[k][tx * 4 + i]; }
#pragma unroll
            for (int i = 0; i < 4; ++i)
#pragma unroll
                for (int j = 0; j < 4; ++j) acc[i][j] += av4[i] * bv4[j];
        }
    }
    if (e.mode == 0 || e.mode == 1) {
#pragma unroll
        for (int i = 0; i < 4; ++i) { const int row = m0 + ty * 4 + i;
#pragma unroll
            for (int j = 0; j < 4; ++j) { float v = acc[i][j]; if (e.mode == 1) { v = v > 0.f ? v : 0.f; v = v * v; }
                e.O[(size_t)row * e.ldc + n0 + tx * 4 + j] = (bf16)f2bf(v); } }
    } else if (e.mode == 2) {
#pragma unroll
        for (int i = 0; i < 4; ++i) { const int row = m0 + ty * 4 + i; const int b = row / SEQ;
#pragma unroll
            for (int j = 0; j < 4; ++j) { const int col = n0 + tx * 4 + j;
                e.out[(size_t)row * D + col] = e.base[(size_t)row * D + col] + e.gate[(size_t)b * e.gstride + col] * acc[i][j]; } }
    } else {
        const int tsel = n0 / D, cbase = n0 % D;
        bf16* dst = tsel == 0 ? e.Q : (tsel == 1 ? e.Kb : e.V);
        float rs[4] = {1.f, 1.f, 1.f, 1.f};
        if (tsel < 2) {
#pragma unroll
            for (int i = 0; i < 4; ++i) { float p = 0.f;
#pragma unroll
                for (int j = 0; j < 4; ++j) p += acc[i][j] * acc[i][j];
                red[ty * 4 + i][tx] = p; }
            __syncthreads();
#pragma unroll
            for (int i = 0; i < 4; ++i) { float s = 0.f;
                for (int x = 0; x < 16; ++x) s += red[ty * 4 + i][x];
                rs[i] = 1.f / sqrtf(s * (1.f / HD) + EPS); }
        }
#pragma unroll
        for (int i = 0; i < 4; ++i) { const int row = m0 + ty * 4 + i;
#pragma unroll
            for (int j = 0; j < 4; ++j) { const int d = tx * 4 + j; float v = acc[i][j];
                if (tsel == 0) v = v * rs[i] * e.qg[d] * QSCALE; else if (tsel == 1) v = v * rs[i] * e.kg[d];
                dst[(size_t)row * D + cbase + d] = (bf16)f2bf(v); } }
    }
}

__global__ void __launch_bounds__(128) naive_lru(const bf16* Z, const float* conv_w, const float* conv_b, const float* wa, const float* ba, const float* wx, const float* bx, const float* lam, bf16* YG) {
    __shared__ float swa[LB * LB];
    __shared__ float swx[LB * LB];
    __shared__ float xcs[LB];
    const int b = blockIdx.x / NLB, n = blockIdx.x % NLB, e = threadIdx.x;
    for (int i = e; i < LB * LB; i += 128) { swa[i] = wa[(size_t)n * LB * LB + i]; swx[i] = wx[(size_t)n * LB * LB + i]; }
    const int ch = n * LB + (e < LB ? e : 0);
    const float cw0 = conv_w[0 * W + ch], cw1 = conv_w[1 * W + ch], cw2 = conv_w[2 * W + ch], cw3 = conv_w[3 * W + ch], cb = conv_b[ch];
    const float bav = ba[ch], bxv = bx[ch];
    const float sp = log1pf(__expf(-lam[ch]));
    float x0 = 0.f, x1 = 0.f, x2 = 0.f, h = 0.f;
    __syncthreads();
    for (int t = 0; t < SEQ; ++t) {
        const size_t row = (size_t)b * SEQ + t;
        const float x3 = bf2f(Z[row * (2 * W) + W + ch]);
        const float gt = bf2f(Z[row * (2 * W) + ch]);
        const float xc = cb + cw0 * x0 + cw1 * x1 + cw2 * x2 + cw3 * x3;
        x0 = x1; x1 = x2; x2 = x3;
        if (e < LB) xcs[e] = xc;
        __syncthreads();
        if (e < LB) {
            float pa = bav, px = bxv;
            for (int d = 0; d < LB; ++d) { const float xd = xcs[d]; pa += xd * swa[d * LB + e]; px += xd * swx[d * LB + e]; }
            const float r = sigmoidf_(pa), ig = sigmoidf_(px);
            const float la = -8.f * r * sp;
            const float av = __expf(la);
            const float mult = sqrtf(-expm1f(2.f * la));
            h = av * h + mult * (ig * xc);
            YG[row * W + ch] = (bf16)f2bf(h * gelu_tanh(gt));
        }
        __syncthreads();
    }
}

__global__ void __launch_bounds__(64) naive_attn(const bf16* Q, const bf16* Kb, const bf16* V, const float* rel_bias, bf16* O) {
    const int ci = blockIdx.x % (SEQ / CHUNK), h = (blockIdx.x / (SEQ / CHUNK)) % H, b = blockIdx.x / (SEQ / CHUNK * H);
    const int qi = threadIdx.x, qpos = ci * CHUNK + qi;
    const size_t qrow = (size_t)b * SEQ + qpos;
    float q[HD];
#pragma unroll
    for (int d = 0; d < HD; ++d) q[d] = bf2f(Q[qrow * D + h * HD + d]);
    const int k_lo = (ci - LEFT) * CHUNK < 0 ? 0 : (ci - LEFT) * CHUNK, k_hi = (ci + 1) * CHUNK;
    const float* rb = rel_bias + h * 257;
    float mx = -1e30f;
    for (int kp = k_lo; kp < k_hi; ++kp) {
        const v4u* kr = (const v4u*)(Kb + ((size_t)b * SEQ + kp) * D + h * HD); float s = 0.f;
#pragma unroll
        for (int c = 0; c < 8; ++c) { const v4u kv = kr[c];
            s += q[8 * c + 0] * bf2f(kv.x & 0xffffu) + q[8 * c + 1] * bf2f(kv.x >> 16) + q[8 * c + 2] * bf2f(kv.y & 0xffffu) + q[8 * c + 3] * bf2f(kv.y >> 16)
               + q[8 * c + 4] * bf2f(kv.z & 0xffffu) + q[8 * c + 5] * bf2f(kv.z >> 16) + q[8 * c + 6] * bf2f(kv.w & 0xffffu) + q[8 * c + 7] * bf2f(kv.w >> 16); }
        int rel = qpos - kp; rel = rel < -128 ? -128 : (rel > 128 ? 128 : rel);
        s += rb[rel + 128] * LOG2E;
        mx = s > mx ? s : mx;
    }
    float o[HD]; float l = 0.f;
#pragma unroll
    for (int d = 0; d < HD; ++d) o[d] = 0.f;
    for (int kp = k_lo; kp < k_hi; ++kp) {
        const v4u* kr = (const v4u*)(Kb + ((size_t)b * SEQ + kp) * D + h * HD); float s = 0.f;
#pragma unroll
        for (int c = 0; c < 8; ++c) { const v4u kv = kr[c];
            s += q[8 * c + 0] * bf2f(kv.x & 0xffffu) + q[8 * c + 1] * bf2f(kv.x >> 16) + q[8 * c + 2] * bf2f(kv.y & 0xffffu) + q[8 * c + 3] * bf2f(kv.y >> 16)
               + q[8 * c + 4] * bf2f(kv.z & 0xffffu) + q[8 * c + 5] * bf2f(kv.z >> 16) + q[8 * c + 6] * bf2f(kv.w & 0xffffu) + q[8 * c + 7] * bf2f(kv.w >> 16); }
        int rel = qpos - kp; rel = rel < -128 ? -128 : (rel > 128 ? 128 : rel);
        s += rb[rel + 128] * LOG2E;
        const float p = exp2f(s - mx); l += p;
        const v4u* vr = (const v4u*)(V + ((size_t)b * SEQ + kp) * D + h * HD);
#pragma unroll
        for (int c = 0; c < 8; ++c) { const v4u vv = vr[c];
            o[8 * c + 0] += p * bf2f(vv.x & 0xffffu); o[8 * c + 1] += p * bf2f(vv.x >> 16); o[8 * c + 2] += p * bf2f(vv.y & 0xffffu); o[8 * c + 3] += p * bf2f(vv.y >> 16);
            o[8 * c + 4] += p * bf2f(vv.z & 0xffffu); o[8 * c + 5] += p * bf2f(vv.z >> 16); o[8 * c + 6] += p * bf2f(vv.w & 0xffffu); o[8 * c + 7] += p * bf2f(vv.w >> 16); }
    }
    const float il = 1.f / l;
#pragma unroll
    for (int d = 0; d < HD; ++d) O[qrow * D + h * HD + d] = (bf16)f2bf(o[d] * il);
}

#ifndef PROBE_MASK
#define PROBE_MASK 0u
#endif
#ifndef FAST_GEMM
#define FAST_GEMM 1
#endif
#ifndef FAST_LRU
#define FAST_LRU 1
#endif
#ifndef FAST_ATTN
#define FAST_ATTN 1
#endif
extern "C" void kernel_launch(void* const* d_in, const int* in_sizes, int n_in, void* d_out, int out_size, void* d_ws, size_t ws_size, hipStream_t stream) {
    static int grid = 0;
    if (grid == 0) {
        if (n_in != 26 || out_size != M * D || ws_size < WS_END) { fprintf(stderr, "kernel_launch: unexpected shapes (n_in %d out %d ws %zu)\n", n_in, out_size, ws_size); grid = -1; return; }
        int dev = 0, cus = 0;
        if (hipGetDevice(&dev) != hipSuccess || hipDeviceGetAttribute(&cus, hipDeviceAttributeMultiprocessorCount, dev) != hipSuccess) { grid = -1; return; }
        if (hipFuncSetAttribute((const void*)mk_fwd, hipFuncAttributeMaxDynamicSharedMemorySize, LDS_BYTES) != hipSuccess) { fprintf(stderr, "kernel_launch: hipFuncSetAttribute failed\n"); grid = -1; return; }
        (void)hipGetLastError();
        grid = cus;
    }
    if (grid < 0) return;
    unsigned char* ws = (unsigned char*)d_ws;
    (void)hipMemsetAsync(ws + WS_CTL, 0, CTL_ZERO_BYTES, stream);
    Args a{};
    for (int i = 0; i < 26; ++i) a.in[i] = (const float*)d_in[i];
    a.out = (float*)d_out; a.ws = ws; a.perm_qk = 0;
    float* out = (float*)d_out; const float* x = (const float*)d_in[0];
    float* mod0 = (float*)(ws + WS_MOD0); float* mod1 = (float*)(ws + WS_MOD1);
    bf16* HNA = (bf16*)(ws + WS_HNA); bf16* HNB = (bf16*)(ws + WS_HNB); bf16* YG = (bf16*)(ws + WS_YG); bf16* Z = (bf16*)(ws + WS_Z); bf16* HB = (bf16*)(ws + WS_BIG);
    bf16* Qb = (bf16*)(ws + WS_Q); bf16* Kb = (bf16*)(ws + WS_K); bf16* Vb = (bf16*)(ws + WS_V); bf16* Ob = (bf16*)(ws + WS_O);
    bf16* WIN = (bf16*)(ws + WS_WIN); bf16* WOUT = (bf16*)(ws + WS_WOUT); bf16* W1 = (bf16*)(ws + WS_W1); bf16* W2 = (bf16*)(ws + WS_W2); bf16* WQKV = (bf16*)(ws + WS_WQKV); bf16* WO = (bf16*)(ws + WS_WO);
    int nli = 0;
    auto mk2 = [&](int p0, int p1) { a.ph_lo = p0; a.ph_hi = p1; a.li = nli++; hipLaunchKernelGGL(mk_fwd, dim3(grid), dim3(NTHREADS), LDS_BYTES, stream, a); };
    auto mk = [&](int p) { mk2(p, p + 1); };
    auto gemm = [&](const bf16* A, const bf16* A2, int a2col, const bf16* Bt, int N, int K, NEpi e) { hipLaunchKernelGGL(naive_gemm, dim3(N / 64, M / 64), dim3(256), 0, stream, A, A2, a2col, Bt, N, K, e); };
    a.perm_qk = FAST_GEMM ? 1 : 0;
#if FAST_GEMM && FAST_LRU && FAST_ATTN
    mk2(P_PRO, P_COUNT);
    if (PROBE_MASK) { a.zg = 1; for (int p = 0; p < P_COUNT; ++p) if ((PROBE_MASK >> p) & 1u) mk(p); }
    (void)mk; (void)gemm; (void)x; (void)out; (void)mod0; (void)mod1; (void)HNA; (void)HNB; (void)YG; (void)Z; (void)HB; (void)Qb; (void)Kb; (void)Vb; (void)Ob; (void)WIN; (void)WOUT; (void)W1; (void)W2; (void)WQKV; (void)WO;
#else
    mk2(P_PRO, P_NORM_A1 + 1);
    if (FAST_GEMM) mk(P_GEMM_IN); else { NEpi e{}; e.mode = 0; e.O = Z; e.ldc = 2 * W; gemm(HNA, HNA, 1 << 30, WIN, 2 * W, D, e); }
    if (FAST_LRU) mk2(P_LRU1, P_LRU2 + 1); else hipLaunchKernelGGL(naive_lru, dim3(BATCH * NLB), dim3(128), 0, stream, Z, (const float*)d_in[9], (const float*)d_in[10], (const float*)d_in[11], (const float*)d_in[12], (const float*)d_in[13], (const float*)d_in[14], (const float*)d_in[15], YG);
    if (FAST_GEMM) mk2(P_GEMM_OUT, P_DN0 + 1 + 1);
    else {
        { NEpi e{}; e.mode = 2; e.base = x; e.out = out; e.gate = mod0 + 2048; e.gstride = 6144; gemm(YG, YG, 1 << 30, WOUT, D, W, e); }
        mk(P_NORM_A2);
        { NEpi e{}; e.mode = 1; e.O = HB; e.ldc = FF; gemm(HNA, HNA, 1 << 30, W1, FF, D, e); }
        { NEpi e{}; e.mode = 2; e.base = out; e.out = out; e.gate = mod0 + 5120; e.gstride = 6144; gemm(HB, HB, 1 << 30, W2, D, FF, e); }
        mk(P_NORM_B);
    }
    if (FAST_GEMM) mk(P_QKV); else { NEpi e{}; e.mode = 3; e.qg = (const float*)d_in[23]; e.kg = (const float*)d_in[21]; e.Q = Qb; e.Kb = Kb; e.V = Vb; gemm(HNA, HNB, D, WQKV, 3 * D, D, e); }
    if (FAST_ATTN) mk(P_ATTN); else hipLaunchKernelGGL(naive_attn, dim3(BATCH * H * (SEQ / CHUNK)), dim3(64), 0, stream, Qb, Kb, Vb, (const float*)d_in[24], Ob);
    if (FAST_GEMM) mk2(P_GEMM_O, P_DN1 + 1);
    else {
        { NEpi e{}; e.mode = 2; e.base = out; e.out = out; e.gate = mod1 + 2048; e.gstride = 6144; gemm(Ob, Ob, 1 << 30, WO, D, D, e); }
        mk(P_NORM_B2);
        { NEpi e{}; e.mode = 1; e.O = HB; e.ldc = FF; gemm(HNA, HNA, 1 << 30, W1 + (size_t)FF * D, FF, D, e); }
        { NEpi e{}; e.mode = 2; e.base = out; e.out = out; e.gate = mod1 + 5120; e.gstride = 6144; gemm(HB, HB, 1 << 30, W2 + (size_t)FF * D, D, FF, e); }
    }
#endif
}
```
